# Optimizing an MI355X kernel written in HIP

```python
import math
import jax, jax.numpy as jnp
from jax import lax
import numpy as np

D_MODEL = 1024
BATCH = 16
SEQ = 2048
DEPTH = 4

MEM_LEN = 256
ROPE_THETA = 500000.0
Q_BLOCK = 128
MLA_HEADS = 8
MLA_NOPE = 64
MLA_ROPE = 32
MLA_V = 64
MLA_Q_LORA = 384
MLA_KV_LORA = 256
DIFF_HEADS = 8
DIFF_D = 64
DIFF_ROT = DIFF_D // 4
MEM_HEADS = 4
MEM_HD = 128
N_BRANCH = 3
D_FF = 4 * D_MODEL
DEEPNORM_ALPHA = (2 * DEPTH) ** 0.25
DEEPNORM_BETA = (8 * DEPTH) ** -0.25
LN_EPS = 1e-5

MLA_OUT = MLA_HEADS * MLA_V
DIFF_QK = DIFF_HEADS * 2 * DIFF_D
DIFF_OUT = DIFF_HEADS * 2 * DIFF_D
MEM_OUT = MEM_HEADS * MEM_HD
BRANCH_W = MLA_OUT + DIFF_OUT + MEM_OUT
IN_SIZES = (MLA_Q_LORA, MLA_KV_LORA, MLA_ROPE, DIFF_QK, DIFF_QK, DIFF_OUT, MEM_OUT, N_BRANCH * D_MODEL)
N_IN = sum(IN_SIZES)

kernel_name = 'hybrid_mla_diffattn_memory_encoder'


def _split_points():
    pts, acc = [], 0
    for s in IN_SIZES[:-1]:
        acc += s
        pts.append(acc)
    return pts


def _rms(x, g, eps=1e-6):
    xf = x.astype(jnp.float32)
    y = xf * lax.rsqrt(jnp.mean(xf * xf, axis=-1, keepdims=True) + eps)
    return (y * g.astype(jnp.float32)).astype(x.dtype)


def _layernorm(x, g, b):
    xf = x.astype(jnp.float32)
    mu = jnp.mean(xf, axis=-1, keepdims=True)
    var = jnp.mean(jnp.square(xf - mu), axis=-1, keepdims=True)
    y = (xf - mu) * lax.rsqrt(var + LN_EPS) * g.astype(jnp.float32) + b.astype(jnp.float32)
    return y.astype(x.dtype)


def _rope_tables(positions, rot_dim, dtype):
    inv = ROPE_THETA ** (-jnp.arange(0, rot_dim, 2, dtype=jnp.float32) / rot_dim)
    ang = positions.astype(jnp.float32)[..., None] * inv
    return jnp.cos(ang).astype(dtype), jnp.sin(ang).astype(dtype)


def _apply_rope(x, cos, sin):
    half = cos.shape[-1]
    shape = cos.shape[:2] + (1,) * (x.ndim - 3) + (half,)
    c, s = cos.reshape(shape), sin.reshape(shape)
    x1, x2, rest = x[..., :half], x[..., half:2 * half], x[..., 2 * half:]
    return jnp.concatenate([x1 * c - x2 * s, x2 * c + x1 * s, rest], axis=-1)


def _sweep_query_blocks(fn, q):
    b, s = q.shape[0], q.shape[1]
    nb = s // Q_BLOCK
    qb = jnp.moveaxis(q.reshape((b, nb, Q_BLOCK) + q.shape[2:]), 1, 0)
    out = jnp.moveaxis(lax.map(fn, qb), 0, 1)
    return out.reshape((b, s) + out.shape[3:])


def _mla_branch(c_q, c_kv, k_pe, q_norm, kv_norm, w_uq, w_ukv, cos, sin):
    b, s, _ = c_q.shape
    q = (_rms(c_q, q_norm) @ w_uq).reshape(b, s, MLA_HEADS, MLA_NOPE + MLA_ROPE)
    q = jnp.concatenate([q[..., :MLA_NOPE], _apply_rope(q[..., MLA_NOPE:], cos, sin)], axis=-1)
    kv = (_rms(c_kv, kv_norm) @ w_ukv).reshape(b, s, MLA_HEADS, MLA_NOPE + MLA_V)
    k_nope, v = kv[..., :MLA_NOPE], kv[..., MLA_NOPE:]
    k_pe = _apply_rope(k_pe, cos, sin)
    scale = (MLA_NOPE + MLA_ROPE) ** -0.5

    def attend(qblk):
        qn, qp = qblk[..., :MLA_NOPE], qblk[..., MLA_NOPE:]
        sc = jnp.einsum('bqhn,bkhn->bhqk', qn, k_nope) + jnp.einsum('bqhr,bkr->bhqk', qp, k_pe)
        p = jax.nn.softmax(sc.astype(jnp.float32) * scale, axis=-1).astype(v.dtype)
        return jnp.einsum('bhqk,bkhv->bqhv', p, v)

    return _sweep_query_blocks(attend, q).reshape(b, s, MLA_OUT)


def _diff_branch(q, k, v, lam, subln, lambda_init, cos, sin):
    b, s, _ = q.shape
    q = _apply_rope(q.reshape(b, s, DIFF_HEADS, 2, DIFF_D), cos, sin)
    k = _apply_rope(k.reshape(b, s, DIFF_HEADS, 2, DIFF_D), cos, sin)
    v = v.reshape(b, s, DIFF_HEADS, 2 * DIFF_D)
    lf = lam.astype(jnp.float32)
    lambda_full = jnp.exp(jnp.sum(lf[0] * lf[1])) - jnp.exp(jnp.sum(lf[2] * lf[3])) + lambda_init
    scale = DIFF_D ** -0.5

    def attend(qblk):
        sc = jnp.einsum('bqhcd,bkhcd->bhcqk', qblk, k).astype(jnp.float32) * scale
        p = jax.nn.softmax(sc, axis=-1)
        w = (p[:, :, 0] - lambda_full * p[:, :, 1]).astype(v.dtype)
        return jnp.einsum('bhqk,bkhe->bqhe', w, v)

    o = _sweep_query_blocks(attend, q)
    o = _rms(o, subln, 1e-5) * (1.0 - lambda_init)
    return o.reshape(b, s, DIFF_OUT)


def _mem_branch(q, mem, w_kv):
    b, s, _ = q.shape
    q = q.reshape(b, s, MEM_HEADS, MEM_HD)
    kv = (mem @ w_kv).reshape(b, mem.shape[1], 2, MEM_HEADS, MEM_HD)
    k, v = kv[:, :, 0], kv[:, :, 1]
    sc = jnp.einsum('bqhd,bmhd->bhqm', q, k).astype(jnp.float32) * (MEM_HD ** -0.5)
    p = jax.nn.softmax(sc, axis=-1).astype(v.dtype)
    return jnp.einsum('bhqm,bmhd->bqhd', p, v).reshape(b, s, MEM_OUT)


def setup_inputs(seed: int = 0) -> dict:
    key = jax.random.key(seed)
    ks = jax.random.split(key, 24)
    f32 = jnp.float32
    L, D = DEPTH, D_MODEL

    def w(k, shape, fan_in, gain=1.0):
        return jax.random.normal(k, shape, f32) * (gain * fan_in ** -0.5)

    def gain(k, shape):
        return 1.0 + 0.02 * jax.random.normal(k, shape, f32)

    def bias(k, shape):
        return 0.02 * jax.random.normal(k, shape, f32)

    x = jax.random.normal(ks[0], (BATCH, SEQ, D), f32)
    mem = jax.random.normal(ks[1], (BATCH, MEM_LEN, D), f32)
    offset = jax.random.randint(ks[2], (BATCH, 1), 0, SEQ, dtype=jnp.int32)
    positions = (jnp.arange(SEQ, dtype=jnp.int32)[None, :] + offset).astype(jnp.int32)
    return {
        'x': x,
        'mem': mem,
        'positions': positions,
        'w_in': w(ks[3], (L, D, N_IN), D),
        'b_gate': bias(ks[4], (L, N_BRANCH, D)),
        'mla_q_norm': gain(ks[5], (L, MLA_Q_LORA)),
        'mla_kv_norm': gain(ks[6], (L, MLA_KV_LORA)),
        'mla_w_uq': w(ks[7], (L, MLA_Q_LORA, MLA_HEADS * (MLA_NOPE + MLA_ROPE)), MLA_Q_LORA),
        'mla_w_ukv': w(ks[8], (L, MLA_KV_LORA, MLA_HEADS * (MLA_NOPE + MLA_V)), MLA_KV_LORA),
        'diff_lambda': 0.1 * jax.random.normal(ks[9], (L, 4, DIFF_D), f32),
        'diff_subln': gain(ks[10], (L, 2 * DIFF_D)),
        'mem_w_kv': w(ks[11], (L, D, 2 * MEM_OUT), D),
        'w_branch': w(ks[12], (L, BRANCH_W, D), BRANCH_W // N_BRANCH),
        'w_out': w(ks[13], (L, D, D), D, DEEPNORM_BETA),
        'ln1_g': gain(ks[14], (L, D)),
        'ln1_b': bias(ks[15], (L, D)),
        'mlp_w1': w(ks[16], (L, D, D_FF), D),
        'mlp_w2': w(ks[17], (L, D_FF, D), D_FF, DEEPNORM_BETA),
        'ln2_g': gain(ks[18], (L, D)),
        'ln2_b': bias(ks[19], (L, D)),
    }


def reference(x, mem, positions, w_in, b_gate, mla_q_norm, mla_kv_norm, mla_w_uq, mla_w_ukv,
              diff_lambda, diff_subln, mem_w_kv, w_branch, w_out, ln1_g, ln1_b,
              mlp_w1, mlp_w2, ln2_g, ln2_b):
    b, s, d = x.shape
    cos_m, sin_m = _rope_tables(positions, MLA_ROPE, x.dtype)
    cos_d, sin_d = _rope_tables(positions, DIFF_ROT, x.dtype)
    splits = _split_points()
    for l in range(DEPTH):
        lambda_init = 0.8 - 0.6 * math.exp(-0.3 * l)
        h = x @ w_in[l]
        c_q, c_kv, k_pe, dq, dk, dv, mq, gate_pre = jnp.split(h, splits, axis=-1)
        o_mla = _mla_branch(c_q, c_kv, k_pe, mla_q_norm[l], mla_kv_norm[l], mla_w_uq[l], mla_w_ukv[l], cos_m, sin_m)
        o_diff = _diff_branch(dq, dk, dv, diff_lambda[l], diff_subln[l], lambda_init, cos_d, sin_d)
        o_mem = _mem_branch(mq, mem, mem_w_kv[l])
        g = jax.nn.sigmoid(gate_pre.reshape(b, s, N_BRANCH, d) + b_gate[l])
        wb = w_branch[l]
        merged = (g[:, :, 0] * (o_mla @ wb[:MLA_OUT])
                  + g[:, :, 1] * (o_diff @ wb[MLA_OUT:MLA_OUT + DIFF_OUT])
                  + g[:, :, 2] * (o_mem @ wb[MLA_OUT + DIFF_OUT:]))
        x = _layernorm(DEEPNORM_ALPHA * x + merged @ w_out[l], ln1_g[l], ln1_b[l])
        f = jnp.square(jax.nn.relu(x @ mlp_w1[l])) @ mlp_w2[l]
        x = _layernorm(DEEPNORM_ALPHA * x + f, ln2_g[l], ln2_b[l])
    return x
```

```cpp
#include <hip/hip_runtime.h>
#include <hip/hip_cooperative_groups.h>
#include <cstdio>
#include <cstdint>
#include <cmath>
namespace cg = cooperative_groups;

namespace pg8 {
#define PG8_LAS __attribute__((address_space(3)))
typedef unsigned short bf16_t;
typedef short bf16x8 __attribute__((ext_vector_type(8)));
typedef float f32x4 __attribute__((ext_vector_type(4)));
typedef unsigned u32x4 __attribute__((ext_vector_type(4)));
constexpr int BM = 256, BK = 64, HALF = 128, HTB = HALF * BK * 2  , STAGE_BYTES = 8 * HTB, NXCD = 8, WGM = 8;

__host__ __device__ __forceinline__ int lds_byte(int r, int c) { const int st = (r >> 4) * 2 + (c >> 5), rr = r & 15, cc = c & 31, ob = rr * 64 + cc * 2; return st * 1024 + (ob ^ (((ob >> 9) & 1) << 5)); }
__host__ __device__ __forceinline__ void stage_rc(int b, int& R, int& C) { const int st = b / 1024, sb = b % 1024, swz = sb ^ (((sb >> 9) & 1) << 5); R = (st >> 1) * 16 + swz / 64; C = (st & 1) * 32 + (swz % 64) / 2; }
__host__ __device__ __forceinline__ int perm32(int rho) { const int n = rho >> 4, i = rho & 15; return 8 * (i >> 2) + 4 * n + (i & 3); }

struct Unit { int pm, pn; };
struct Gemm { const bf16_t* A; const bf16_t* Bt; int M, N, K, lda, ldb; };

struct StaticOrder {
    int nM, nN, nwg, G, c;
    __host__ __device__ void init(int M, int N, int G_, int c_) { nM = M / BM; nN = N / BM; nwg = nM * nN; G = G_; c = c_; }
    __host__ __device__ bool next(int i, Unit& u) const {
        const long L = (long)i * G + c; if (L >= nwg) return false;
        int wgid = (int)L; { const int q = nwg / NXCD, r = nwg % NXCD, xcd = wgid % NXCD, off = wgid / NXCD; wgid = (xcd < r ? xcd * (q + 1) : r * (q + 1) + (xcd - r) * q) + off; }
        const int nig = WGM * nN, gid = wgid / nig, fm = gid * WGM, gsz = (nM - fm) < WGM ? (nM - fm) : WGM;
        u.pm = fm + ((wgid % nig) % gsz); u.pn = (wgid % nig) / gsz; return true;
    }
    __device__ __forceinline__ void a_ready(const Unit&) const {}
    __device__ __forceinline__ void done(const Unit&) const {}
};

__device__ __forceinline__ unsigned cvt_pk_bf16(float lo, float hi) { unsigned r; asm volatile("v_cvt_pk_bf16_f32 %0, %1, %2" : "=v"(r) : "v"(lo), "v"(hi)); return r; }
__device__ __forceinline__ u32x4 pack8(const f32x4 v0, const f32x4 v1) { u32x4 w; w.x = cvt_pk_bf16(v0[0], v0[1]); w.y = cvt_pk_bf16(v0[2], v0[3]); w.z = cvt_pk_bf16(v1[0], v1[1]); w.w = cvt_pk_bf16(v1[2], v1[3]); return w; }
__device__ __forceinline__ u32x4 ld16_l2(const bf16_t* p) { const unsigned long long* q = (const unsigned long long*)p; const unsigned long long a = __hip_atomic_load(q, __ATOMIC_RELAXED, __HIP_MEMORY_SCOPE_AGENT), b = __hip_atomic_load(q + 1, __ATOMIC_RELAXED, __HIP_MEMORY_SCOPE_AGENT);
    u32x4 r; r.x = (unsigned)a; r.y = (unsigned)(a >> 32); r.z = (unsigned)b; r.w = (unsigned)(b >> 32); return r; }
__device__ __forceinline__ void st16(void* p, const u32x4 w) { unsigned long long* q = (unsigned long long*)p;
    __hip_atomic_store(q, (unsigned long long)w.x | ((unsigned long long)w.y << 32), __ATOMIC_RELAXED, __HIP_MEMORY_SCOPE_SYSTEM);
    __hip_atomic_store(q + 1, (unsigned long long)w.z | ((unsigned long long)w.w << 32), __ATOMIC_RELAXED, __HIP_MEMORY_SCOPE_SYSTEM); }
__device__ __forceinline__ float sgm(float v) { return __builtin_amdgcn_rcpf(1.f + __expf(-v)); }
__device__ __forceinline__ float bflo(unsigned w) { return __uint_as_float(w << 16); }
__device__ __forceinline__ float bfhi(unsigned w) { return __uint_as_float(w & 0xffff0000u); }
__device__ __forceinline__ f32x4 shx4(const f32x4 v, int m) { f32x4 r; r[0] = __shfl_xor(v[0], m); r[1] = __shfl_xor(v[1], m); r[2] = __shfl_xor(v[2], m); r[3] = __shfl_xor(v[3], m); return r; }

struct EpiH {
    static constexpr bool PERM = true, AFTER_DRAIN = false;
    bf16_t *lat, *dq, *dk, *dv, *mq; const float *cosd, *sind, *cosm, *sinm;
    __device__ __forceinline__ void operator()(const f32x4 (&acc)[2][2][4][2], const Unit& u, int wr, int wc, int fr, int fq) const {
        const int pn = u.pn; bf16_t* base; int ld, c0, mode;
        if (pn < 3) { base = lat; ld = 768; c0 = pn * 256; mode = (pn == 2) ? 2 : 0; }
        else if (pn < 7) { base = dq; ld = 1024; c0 = (pn - 3) * 256; mode = 1; }
        else if (pn < 11) { base = dk; ld = 1024; c0 = (pn - 7) * 256; mode = 1; }
        else if (pn < 15) { base = dv; ld = 1024; c0 = (pn - 11) * 256; mode = 0; }
        else { base = mq; ld = 512; c0 = (pn - 15) * 256; mode = 0; }
        const int row0 = u.pm * BM + wr * 64 + fr, colw = c0 + wc * 32 + 8 * fq;
#pragma unroll
        for (int ai = 0; ai < 2; ++ai)
#pragma unroll
            for (int m = 0; m < 4; ++m) { const int row = row0 + ai * HALF + m * 16; bf16_t* rowp = base + (size_t)row * ld + colw;
#pragma unroll
                for (int bj = 0; bj < 2; ++bj) { f32x4 v0 = acc[ai][bj][m][0], v1 = acc[ai][bj][m][1];
                    if (mode == 1 && (wc & 1) == 0) {
                        const f32x4 p0 = shx4(v0, 16), p1 = shx4(v1, 16);
                        if (fq < 2) { const f32x4 c0v = *(const f32x4*)(cosd + (size_t)row * 8), c1v = *(const f32x4*)(cosd + (size_t)row * 8 + 4);
                            f32x4 s0v = *(const f32x4*)(sind + (size_t)row * 8), s1v = *(const f32x4*)(sind + (size_t)row * 8 + 4);
                            if (fq == 0) { s0v = -s0v; s1v = -s1v; }
                            v0 = v0 * c0v + p0 * s0v; v1 = v1 * c1v + p1 * s1v; } }
                    if (mode == 2 && bj == 1 && wc == 0) {
                        const f32x4 p0 = shx4(v0, 32), p1 = shx4(v1, 32); const int i16 = (fq & 1) * 8;
                        const f32x4 c0v = *(const f32x4*)(cosm + (size_t)row * 16 + i16), c1v = *(const f32x4*)(cosm + (size_t)row * 16 + i16 + 4);
                        f32x4 s0v = *(const f32x4*)(sinm + (size_t)row * 16 + i16), s1v = *(const f32x4*)(sinm + (size_t)row * 16 + i16 + 4);
                        if (fq < 2) { s0v = -s0v; s1v = -s1v; }
                        v0 = v0 * c0v + p0 * s0v; v1 = v1 * c1v + p1 * s1v; }
                    *(u32x4*)(rowp + bj * HALF) = pack8(v0, v1); }
                asm volatile("" ::: "memory"); }
    }
};
template <bool ROPE> struct EpiScale {
    static constexpr bool PERM = true, AFTER_DRAIN = false;
    bf16_t* O; int ld; const float* rs; const float *cosm, *sinm;
    __device__ __forceinline__ void operator()(const f32x4 (&acc)[2][2][4][2], const Unit& u, int wr, int wc, int fr, int fq) const {
        const int row0 = u.pm * BM + wr * 64 + fr, colw = u.pn * BM + wc * 32 + 8 * fq;
#pragma unroll
        for (int ai = 0; ai < 2; ++ai)
#pragma unroll
            for (int m = 0; m < 4; ++m) { const int row = row0 + ai * HALF + m * 16; bf16_t* rowp = O + (size_t)row * ld + colw;
                const float sc = rs ? __hip_atomic_load(rs + row, __ATOMIC_RELAXED, __HIP_MEMORY_SCOPE_AGENT) : 1.f;
#pragma unroll
                for (int bj = 0; bj < 2; ++bj) { f32x4 v0 = acc[ai][bj][m][0] * sc, v1 = acc[ai][bj][m][1] * sc;
                    if (ROPE && u.pn == 2) {
                        const f32x4 p0 = shx4(v0, 32), p1 = shx4(v1, 32); const int i16 = (fq & 1) * 8;
                        const f32x4 c0v = *(const f32x4*)(cosm + (size_t)row * 16 + i16), c1v = *(const f32x4*)(cosm + (size_t)row * 16 + i16 + 4);
                        f32x4 s0v = *(const f32x4*)(sinm + (size_t)row * 16 + i16), s1v = *(const f32x4*)(sinm + (size_t)row * 16 + i16 + 4);
                        if (fq < 2) { s0v = -s0v; s1v = -s1v; }
                        v0 = v0 * c0v + p0 * s0v; v1 = v1 * c1v + p1 * s1v; }
                    *(u32x4*)(rowp + bj * HALF) = pack8(v0, v1); }
                asm volatile("" ::: "memory"); }
    }
};
struct EpiGate {
    static constexpr bool PERM = true, AFTER_DRAIN = false;
    bf16_t* G; const float* bias;
    __device__ __forceinline__ void operator()(const f32x4 (&acc)[2][2][4][2], const Unit& u, int wr, int wc, int fr, int fq) const {
        const int row0 = u.pm * BM + wr * 64 + fr, colw = u.pn * BM + wc * 32 + 8 * fq;
        f32x4 bv[2][2];
#pragma unroll
        for (int bj = 0; bj < 2; ++bj)
#pragma unroll
            for (int n = 0; n < 2; ++n) bv[bj][n] = *(const f32x4*)(bias + colw + bj * HALF + 4 * n);
#pragma unroll
        for (int ai = 0; ai < 2; ++ai)
#pragma unroll
            for (int m = 0; m < 4; ++m) { bf16_t* rowp = G + (size_t)(row0 + ai * HALF + m * 16) * 1024 + colw;
#pragma unroll
                for (int bj = 0; bj < 2; ++bj) { f32x4 v0 = acc[ai][bj][m][0] + bv[bj][0], v1 = acc[ai][bj][m][1] + bv[bj][1];
                    *(u32x4*)(rowp + bj * HALF) = pack8(v0, v1); }
                asm volatile("" ::: "memory"); }
    }
};
template <bool FIRST> struct EpiBranch {
    static constexpr bool PERM = true, AFTER_DRAIN = false;
    const bf16_t* G; bf16_t* Mg;
    __device__ __forceinline__ void operator()(const f32x4 (&acc)[2][2][4][2], const Unit& u, int wr, int wc, int fr, int fq) const {
        const int row0 = u.pm * BM + wr * 64 + fr, colw = u.pn * BM + wc * 32 + 8 * fq;
#pragma unroll
        for (int ai = 0; ai < 2; ++ai)
#pragma unroll
            for (int m = 0; m < 4; ++m) { const size_t off = (size_t)(row0 + ai * HALF + m * 16) * 1024 + colw;
#pragma unroll
                for (int bj = 0; bj < 2; ++bj) { const u32x4 g = *(const u32x4*)(G + off + bj * HALF);
                    f32x4 v0 = acc[ai][bj][m][0], v1 = acc[ai][bj][m][1];
                    v0[0] *= sgm(bflo(g.x)); v0[1] *= sgm(bfhi(g.x)); v0[2] *= sgm(bflo(g.y)); v0[3] *= sgm(bfhi(g.y)); v1[0] *= sgm(bflo(g.z)); v1[1] *= sgm(bfhi(g.z)); v1[2] *= sgm(bflo(g.w)); v1[3] *= sgm(bfhi(g.w));
                    if (!FIRST) { const u32x4 o = *(const u32x4*)(Mg + off + bj * HALF);
                        v0[0] += bflo(o.x); v0[1] += bfhi(o.x); v0[2] += bflo(o.y); v0[3] += bfhi(o.y); v1[0] += bflo(o.z); v1[1] += bfhi(o.z); v1[2] += bflo(o.w); v1[3] += bfhi(o.w); }
                    *(u32x4*)(Mg + off + bj * HALF) = pack8(v0, v1); }
                asm volatile("" ::: "memory"); }
    }
};
struct EpiRes {
    static constexpr bool PERM = false, AFTER_DRAIN = false;
    float* X; float alpha;
    __device__ __forceinline__ void operator()(const f32x4 (&acc)[2][2][4][2], const Unit& u, int wr, int wc, int fr, int fq) const {
        const int row0 = u.pm * BM + wr * 64 + fr, col0 = u.pn * BM + wc * 32 + 4 * fq;
        float* base = X + (size_t)row0 * 1024 + col0;
        f32x4 xq[2][2][2];
#pragma unroll
        for (int bj = 0; bj < 2; ++bj)
#pragma unroll
            for (int n = 0; n < 2; ++n) xq[0][bj][n] = *(const f32x4*)(base + bj * HALF + n * 16);
#pragma unroll
        for (int it = 0; it < 8; ++it) { const int ai = it >> 2, m = it & 3, cur = it & 1; float* rowp = base + (size_t)(ai * HALF + m * 16) * 1024;
            if (it < 7) { const float* rown = base + (size_t)(((it + 1) >> 2) * HALF + ((it + 1) & 3) * 16) * 1024;
#pragma unroll
                for (int bj = 0; bj < 2; ++bj)
#pragma unroll
                    for (int n = 0; n < 2; ++n) xq[cur ^ 1][bj][n] = *(const f32x4*)(rown + bj * HALF + n * 16); }
#pragma unroll
            for (int bj = 0; bj < 2; ++bj)
#pragma unroll
                for (int n = 0; n < 2; ++n) *(f32x4*)(rowp + bj * HALF + n * 16) = xq[cur][bj][n] * alpha + acc[ai][bj][m][n];
            asm volatile("" ::: "memory"); }
    }
};
struct EpiRelu2 {
    static constexpr bool PERM = true, AFTER_DRAIN = false;
    bf16_t* H; int ld;
    __device__ __forceinline__ void operator()(const f32x4 (&acc)[2][2][4][2], const Unit& u, int wr, int wc, int fr, int fq) const {
        const int row0 = u.pm * BM + wr * 64 + fr, colw = u.pn * BM + wc * 32 + 8 * fq;
#pragma unroll
        for (int ai = 0; ai < 2; ++ai)
#pragma unroll
            for (int m = 0; m < 4; ++m) { bf16_t* rowp = H + (size_t)(row0 + ai * HALF + m * 16) * ld + colw;
#pragma unroll
                for (int bj = 0; bj < 2; ++bj) { f32x4 v0 = acc[ai][bj][m][0], v1 = acc[ai][bj][m][1];
#pragma unroll
                    for (int e = 0; e < 4; ++e) { const float a = fmaxf(v0[e], 0.f), b = fmaxf(v1[e], 0.f); v0[e] = a * a; v1[e] = b * b; }
                    *(u32x4*)(rowp + bj * HALF) = pack8(v0, v1); }
                asm volatile("" ::: "memory"); }
    }
};

template <class Epi, class Sched, bool ALIGN_EPI = false, bool SP2 = false>
__device__ __forceinline__ void gemm_phase(PG8_LAS unsigned char* lds, const Gemm g, const Sched& S, const Epi& E) {
    int tid_ = threadIdx.x; asm volatile("" : "+v"(tid_));
    const int tid = tid_, wid = __builtin_amdgcn_readfirstlane(tid >> 6), lane = tid & 63, wr = wid >> 2, wc = wid & 3, fr = lane & 15, fq = lane >> 4;
    int K_ = g.K; asm volatile("" : "+s"(K_));
    const int K = K_, nt = K / BK;
    unsigned voffA[2], voffB[2];
#pragma unroll
    for (int i = 0; i < 2; ++i) { int R, C; stage_rc(tid * 16 + i * 8192, R, C); const int Rb = Epi::PERM ? ((R & ~31) + perm32(R & 31)) : R;
        voffA[i] = (unsigned)(R * g.lda + C) * 2u; voffB[i] = (unsigned)(Rb * g.ldb + C) * 2u; }
    const size_t kstep = (size_t)(BK * 2);
    const size_t hstepA = (size_t)HALF * g.lda * 2, hstepB = (size_t)HALF * g.ldb * 2;
    const size_t tstepA = 2 * hstepA, tstepB = 2 * hstepB;
    const unsigned ldsw = (unsigned)wid * 1024u;
    const int aoff = lds_byte(wr * 64 + fr, fq * 8), boff = lds_byte(wc * 32 + fr, fq * 8);
#define PG8_SA(b, h) (((b) * 2 + (h)) * HTB)
#define PG8_SB(b, h) ((4 + (b) * 2 + (h)) * HTB)
#define PG8_STAGE(bufoff, gbase, voff) do { _Pragma("unroll") for (int _i = 0; _i < 2; ++_i) \
        __builtin_amdgcn_global_load_lds((const unsigned*)((const char*)(gbase) + (voff)[_i]), (PG8_LAS unsigned*)(lds + (bufoff) + ldsw + _i * 8192), 16, 0, 0); } while (0)
#define PG8_LDA(dst, b, h) do { _Pragma("unroll") for (int m = 0; m < 4; ++m) _Pragma("unroll") for (int k = 0; k < 2; ++k) dst[m][k] = *(const PG8_LAS bf16x8*)(lds + PG8_SA(b, h) + aoff + m * 2048 + k * 1024); } while (0)
#define PG8_LDB(dst, b, h) do { _Pragma("unroll") for (int n = 0; n < 2; ++n) _Pragma("unroll") for (int k = 0; k < 2; ++k) dst[n][k] = *(const PG8_LAS bf16x8*)(lds + PG8_SB(b, h) + boff + n * 2048 + k * 1024); } while (0)
#define PG8_MMA(ai, bj, At, Bt) do { __builtin_amdgcn_s_setprio(1); _Pragma("unroll") for (int m = 0; m < 4; ++m) _Pragma("unroll") for (int n = 0; n < 2; ++n) _Pragma("unroll") for (int k = 0; k < 2; ++k) \
        acc[ai][bj][m][n] = __builtin_amdgcn_mfma_f32_16x16x32_bf16(Bt[n][k], At[m][k], acc[ai][bj][m][n], 0, 0, 0); __builtin_amdgcn_s_setprio(0); } while (0)
#define PG8_WAIT_V(n) asm volatile("s_waitcnt vmcnt(" #n ")" ::: "memory")
#define PG8_WAIT_L(n) asm volatile("s_waitcnt lgkmcnt(" #n ")" ::: "memory")
#define PG8_BAR __builtin_amdgcn_s_barrier()
#define PG8_SCHED __builtin_amdgcn_sched_barrier(0)
    Unit cur, nxt; int ui = 0;
    if (!S.next(0, cur)) return;
    f32x4 acc[2][2][4][2];
#pragma unroll
    for (int a = 0; a < 2; ++a)
#pragma unroll
        for (int b = 0; b < 2; ++b)
#pragma unroll
            for (int m = 0; m < 4; ++m)
#pragma unroll
                for (int n = 0; n < 2; ++n) acc[a][b][m][n] = (f32x4){0.f, 0.f, 0.f, 0.f};
    bf16x8 At[4][2], B0[2][2], B1[2][2];
    const char* cA = (const char*)g.A + (size_t)cur.pm * tstepA; const char* cB = (const char*)g.Bt + (size_t)cur.pn * tstepB;
    S.a_ready(cur);
    if constexpr (SP2) {
        PG8_STAGE(PG8_SB(0, 0), cB, voffB); PG8_STAGE(PG8_SB(0, 1), cB + hstepB, voffB); PG8_STAGE(PG8_SA(0, 0), cA, voffA); PG8_STAGE(PG8_SA(0, 1), cA + hstepA, voffA);
        if (wr == 1) PG8_BAR;
        PG8_WAIT_V(2); PG8_BAR;
        PG8_STAGE(PG8_SB(1, 0), cB + kstep, voffB); PG8_STAGE(PG8_SA(1, 0), cA + kstep, voffA); PG8_STAGE(PG8_SB(1, 1), cB + hstepB + kstep, voffB);
        PG8_WAIT_V(6); PG8_BAR;
    } else {
        PG8_STAGE(PG8_SB(0, 0), cB, voffB); PG8_STAGE(PG8_SA(0, 0), cA, voffA); PG8_STAGE(PG8_SB(0, 1), cB + hstepB, voffB); PG8_STAGE(PG8_SA(0, 1), cA + hstepA, voffA);
        if (wr == 1) PG8_BAR;
        PG8_WAIT_V(4); PG8_BAR;
        PG8_STAGE(PG8_SB(1, 0), cB + kstep, voffB); PG8_STAGE(PG8_SA(1, 0), cA + kstep, voffA); PG8_STAGE(PG8_SB(1, 1), cB + hstepB + kstep, voffB);
        PG8_WAIT_V(6); PG8_BAR;
    }
    for (;;) {
        const bool has_next = S.next(ui + 1, nxt);
        const char* nA = has_next ? (const char*)g.A + (size_t)nxt.pm * tstepA : cA; const char* nB = has_next ? (const char*)g.Bt + (size_t)nxt.pn * tstepB : cB;
        for (int t = 0; t < nt; t += 2) {
            const bool last = (t == nt - 2);
            const char* a1 = cA + (size_t)(t + 1) * kstep;
            const char* a2 = last ? nA : cA + (size_t)(t + 2) * kstep; const char* b2 = last ? nB : cB + (size_t)(t + 2) * kstep;
            const char* a3 = a2 + kstep; const char* b3 = b2 + kstep;
            if (last && has_next) S.a_ready(nxt);
            if constexpr (SP2) {
            PG8_LDB(B0, 0, 0); PG8_LDB(B1, 0, 1); PG8_SCHED; PG8_LDA(At, 0, 0); PG8_STAGE(PG8_SA(1, 1), a1 + hstepA, voffA);
            PG8_WAIT_V(8); PG8_WAIT_L(0); PG8_BAR; PG8_MMA(0, 0, At, B0); PG8_MMA(0, 1, At, B1); PG8_BAR; PG8_SCHED;
            PG8_LDA(At, 0, 1); PG8_STAGE(PG8_SB(0, 0), b2, voffB); PG8_STAGE(PG8_SB(0, 1), b2 + hstepB, voffB); PG8_STAGE(PG8_SA(0, 0), a2, voffA);
            PG8_WAIT_V(8); PG8_WAIT_L(0); PG8_BAR; PG8_MMA(1, 0, At, B0); PG8_MMA(1, 1, At, B1); PG8_BAR; PG8_SCHED;
            PG8_LDB(B0, 1, 0); PG8_LDB(B1, 1, 1); PG8_SCHED; PG8_LDA(At, 1, 0); PG8_STAGE(PG8_SA(0, 1), a2 + hstepA, voffA);
            PG8_WAIT_V(8); PG8_WAIT_L(0); PG8_BAR; PG8_MMA(0, 0, At, B0); PG8_MMA(0, 1, At, B1); PG8_BAR; PG8_SCHED;
            PG8_LDA(At, 1, 1); PG8_STAGE(PG8_SB(1, 0), b3, voffB); PG8_STAGE(PG8_SB(1, 1), b3 + hstepB, voffB); PG8_STAGE(PG8_SA(1, 0), a3, voffA);
            PG8_WAIT_V(8); PG8_WAIT_L(0); PG8_BAR; PG8_MMA(1, 0, At, B0); PG8_MMA(1, 1, At, B1); PG8_BAR; PG8_SCHED;
            } else {
            PG8_LDB(B0, 0, 0); PG8_SCHED; PG8_LDA(At, 0, 0); PG8_STAGE(PG8_SA(1, 1), a1 + hstepA, voffA);
            PG8_WAIT_L(8); PG8_BAR; PG8_WAIT_L(0); PG8_MMA(0, 0, At, B0); PG8_BAR; PG8_SCHED;
            PG8_LDB(B1, 0, 1); PG8_STAGE(PG8_SB(0, 0), b2, voffB);
            PG8_BAR; PG8_WAIT_L(0); PG8_MMA(0, 1, At, B1); PG8_BAR;
            PG8_LDA(At, 0, 1); PG8_STAGE(PG8_SA(0, 0), a2, voffA);
            PG8_BAR; PG8_WAIT_L(0); PG8_MMA(1, 0, At, B0); PG8_BAR; PG8_SCHED;
            PG8_STAGE(PG8_SB(0, 1), b2 + hstepB, voffB);
            PG8_WAIT_V(6); PG8_BAR; PG8_MMA(1, 1, At, B1); PG8_BAR;
            PG8_LDB(B0, 1, 0); PG8_SCHED; PG8_LDA(At, 1, 0); PG8_STAGE(PG8_SA(0, 1), a2 + hstepA, voffA);
            PG8_WAIT_L(8); PG8_BAR; PG8_WAIT_L(0); PG8_MMA(0, 0, At, B0); PG8_BAR; PG8_SCHED;
            PG8_LDB(B1, 1, 1); PG8_STAGE(PG8_SB(1, 0), b3, voffB);
            PG8_BAR; PG8_WAIT_L(0); PG8_MMA(0, 1, At, B1); PG8_BAR;
            PG8_LDA(At, 1, 1); PG8_STAGE(PG8_SA(1, 0), a3, voffA);
            PG8_BAR; PG8_WAIT_L(0); PG8_MMA(1, 0, At, B0); PG8_BAR; PG8_SCHED;
            PG8_STAGE(PG8_SB(1, 1), b3 + hstepB, voffB);
            PG8_WAIT_V(6); PG8_BAR; PG8_MMA(1, 1, At, B1); PG8_BAR;
            }
        }
        if constexpr (ALIGN_EPI) { if (wr == 0) PG8_BAR; }
        if constexpr (!Epi::AFTER_DRAIN) { E(acc, cur, wr, wc, fr, fq); S.done(cur); }
        if (!has_next) break;
#pragma unroll
        for (int a = 0; a < 2; ++a)
#pragma unroll
            for (int b = 0; b < 2; ++b)
#pragma unroll
                for (int m = 0; m < 4; ++m)
#pragma unroll
                    for (int n = 0; n < 2; ++n) acc[a][b][m][n] = (f32x4){0.f, 0.f, 0.f, 0.f};
        cur = nxt; cA = nA; cB = nB; ++ui;
        if constexpr (ALIGN_EPI) { if (wr == 1) PG8_BAR; }
    }
    PG8_WAIT_V(0);
    if constexpr (!ALIGN_EPI) { if (wr == 0) PG8_BAR; }
    PG8_BAR;
    if constexpr (Epi::AFTER_DRAIN) { E.fused(acc, cur, wr, wc, fr, fq, lds, wid, lane); S.done(cur); }
#undef PG8_SA
#undef PG8_SB
#undef PG8_STAGE
#undef PG8_LDA
#undef PG8_LDB
#undef PG8_MMA
#undef PG8_WAIT_V
#undef PG8_WAIT_L
#undef PG8_BAR
#undef PG8_SCHED
}
}

namespace att {
#define LAS __attribute__((address_space(3)))
typedef unsigned short bf16_t;
typedef LAS char* lptr;
using bf16x8 = __attribute__((ext_vector_type(8))) short;
using s16x4  = __attribute__((ext_vector_type(4))) short;
using f32x16 = __attribute__((ext_vector_type(16))) float;
using u32x4  = __attribute__((ext_vector_type(4))) unsigned;
constexpr int V_OFF = 0, K_OFF = 32768, WS_OFF = 67584, STASH_OFF = 69632, ATT_LDS_END = STASH_OFF + 65536;
#define SBAR() __builtin_amdgcn_sched_barrier(0)
__device__ __forceinline__ int crow(int r, int hi) { return (r & 3) + 8 * (r >> 2) + 4 * hi; }
__device__ __forceinline__ unsigned cvtpk(float lo, float hi) { unsigned r; asm volatile("v_cvt_pk_bf16_f32 %0, %1, %2" : "=v"(r) : "v"(lo), "v"(hi)); return r; }
__device__ __forceinline__ unsigned short f2bf(float f) { unsigned u = __builtin_bit_cast(unsigned, f); return (unsigned short)((u + 0x7fffu + ((u >> 16) & 1u)) >> 16); }

struct Args { const bf16_t *Q0, *Q1, *K0, *K1, *V; int ldq, ldk0, ldk1, ldv, nkeys; float C, thr; };

__device__ __forceinline__ void partialSM(f32x16& p0, f32x16& p1, float& m_reg, float& mn, float& alpha, float C, float thr) {
  float pmax = p0[0];
#pragma unroll
  for (int r = 1; r < 16; ++r) pmax = fmaxf(pmax, p0[r]);
#pragma unroll
  for (int r = 0; r < 16; ++r) pmax = fmaxf(pmax, p1[r]);
  { auto rr = __builtin_amdgcn_permlane32_swap(__float_as_uint(pmax), __float_as_uint(pmax), false, false);
    pmax = fmaxf(__uint_as_float(rr[0]), __uint_as_float(rr[1])); }
  if (__builtin_expect(__all(pmax - m_reg <= thr), 1)) { mn = m_reg; alpha = 1.f; }
  else { mn = fmaxf(m_reg, pmax); alpha = __builtin_amdgcn_exp2f((m_reg - mn) * C); m_reg = mn; }
  const float mnC = -mn * C;
#pragma unroll
  for (int r = 0; r < 16; ++r) p0[r] = fmaf(p0[r], C, mnC);
#pragma unroll
  for (int r = 0; r < 16; ++r) p1[r] = fmaf(p1[r], C, mnC);
#pragma unroll
  for (int r = 0; r < 16; ++r) p0[r] = __builtin_amdgcn_exp2f(p0[r]);
}
__device__ __forceinline__ void finishSM(f32x16& p0, f32x16& p1, float alpha, float& l_reg, bf16x8& pa0, bf16x8& pa1, bf16x8& pa2, bf16x8& pa3) {
#pragma unroll
  for (int r = 0; r < 16; ++r) p1[r] = __builtin_amdgcn_exp2f(p1[r]);
  float ps = 0;
#pragma unroll
  for (int r = 0; r < 16; ++r) ps += p0[r];
#pragma unroll
  for (int r = 0; r < 16; ++r) ps += p1[r];
  { auto rr = __builtin_amdgcn_permlane32_swap(__float_as_uint(ps), __float_as_uint(ps), false, false);
    ps = __uint_as_float(rr[0]) + __uint_as_float(rr[1]); }
  l_reg = l_reg * alpha + ps;
#define PK4(P, BASE, OUT) do { unsigned a0 = cvtpk(P[BASE + 0], P[BASE + 1]), a1 = cvtpk(P[BASE + 2], P[BASE + 3]);   \
    unsigned b0 = cvtpk(P[BASE + 4], P[BASE + 5]), b1 = cvtpk(P[BASE + 6], P[BASE + 7]);                              \
    auto r0 = __builtin_amdgcn_permlane32_swap(a0, b0, false, false); auto r1 = __builtin_amdgcn_permlane32_swap(a1, b1, false, false); \
    u32x4 w = {r0[0], r1[0], r0[1], r1[1]}; OUT = __builtin_bit_cast(bf16x8, w); } while (0)
  PK4(p0, 0, pa0); PK4(p0, 8, pa1); PK4(p1, 0, pa2); PK4(p1, 8, pa3);
#undef PK4
}
template <int NQ, int KROW> __device__ __forceinline__ void qkt(f32x16& p0, f32x16& p1, lptr Ks, const bf16x8* qr, int r32, int hi) {
  p0 = f32x16{}; p1 = f32x16{};
#pragma unroll
  for (int d0 = 0; d0 < NQ; ++d0) { const int cb = (d0 * 16 + hi * 8) * 2;
    const bf16x8 b0 = *(const LAS bf16x8*)(Ks + r32 * KROW + cb);
    const bf16x8 b1 = *(const LAS bf16x8*)(Ks + (32 + r32) * KROW + cb);
    p0 = __builtin_amdgcn_mfma_f32_32x32x16_bf16(b0, qr[d0], p0, 0, 0, 0);
    p1 = __builtin_amdgcn_mfma_f32_32x32x16_bf16(b1, qr[d0], p1, 0, 0, 0); }
}
template <int ND> __device__ __forceinline__ int v_st(int k, int c) { const int kk = (k & ~0xC) | ((k & 4) << 1) | ((k & 8) >> 1); return ((kk >> 3) * ND + (c >> 5)) * 512 + ((kk & 7) * 32 + (c & 31)) * 2; }
__device__ __forceinline__ int v_rd_base(int lane) { return ((lane & 3) << 3) | (((lane >> 2) & 3) << 6) | (((lane >> 4) & 1) << 5) | (((lane >> 5) & 1) << 8); }
template <int OFF> __device__ __forceinline__ s16x4 tr_read(int vb) {
  s16x4 r; asm volatile("ds_read_b64_tr_b16 %0, %1 offset:%2" : "=&v"(r) : "v"(vb), "i"(OFF) : "memory"); return r;
}
template <int ND, int D0> __device__ __forceinline__ void pv_one(f32x16& od, int vb, bf16x8 pa0, bf16x8 pa1, bf16x8 pa2, bf16x8 pa3) {
  constexpr int KG = ND * 512;
  const s16x4 l0 = tr_read<D0 * 512 + 0 * KG>(vb), h0 = tr_read<D0 * 512 + 1 * KG>(vb), l1 = tr_read<D0 * 512 + 2 * KG>(vb), h1 = tr_read<D0 * 512 + 3 * KG>(vb);
  const s16x4 l2 = tr_read<D0 * 512 + 4 * KG>(vb), h2 = tr_read<D0 * 512 + 5 * KG>(vb), l3 = tr_read<D0 * 512 + 6 * KG>(vb), h3 = tr_read<D0 * 512 + 7 * KG>(vb);
  asm volatile("s_waitcnt lgkmcnt(0)" ::: "memory"); SBAR();
#define PK(L, H) (bf16x8){L[0], L[1], L[2], L[3], H[0], H[1], H[2], H[3]}
  od = __builtin_amdgcn_mfma_f32_32x32x16_bf16(pa0, PK(l0, h0), od, 0, 0, 0);
  od = __builtin_amdgcn_mfma_f32_32x32x16_bf16(pa1, PK(l1, h1), od, 0, 0, 0);
  od = __builtin_amdgcn_mfma_f32_32x32x16_bf16(pa2, PK(l2, h2), od, 0, 0, 0);
  od = __builtin_amdgcn_mfma_f32_32x32x16_bf16(pa3, PK(l3, h3), od, 0, 0, 0);
#undef PK
}
template <int ND> __device__ __forceinline__ void pv_all(f32x16* o, int vb, bf16x8 pa0, bf16x8 pa1, bf16x8 pa2, bf16x8 pa3) {
  pv_one<ND, 0>(o[0], vb, pa0, pa1, pa2, pa3); pv_one<ND, 1>(o[1], vb, pa0, pa1, pa2, pa3);
  if constexpr (ND == 4) { pv_one<ND, 2>(o[2], vb, pa0, pa1, pa2, pa3); pv_one<ND, 3>(o[3], vb, pa0, pa1, pa2, pa3); }
}

template <int MODE> struct Cfg;
template <> struct Cfg<0> { static constexpr int DQK = 96, DV = 64; };
template <> struct Cfg<1> { static constexpr int DQK = 64, DV = 128; };
template <> struct Cfg<2> { static constexpr int DQK = 128, DV = 128; };

struct Slot { bf16x8 a, b, c, d; };

template <int MODE>
__device__ __forceinline__ void attn_core(const Args& A, lptr lds, f32x16* o, float* rli) {
  constexpr int DQK = Cfg<MODE>::DQK, DV = Cfg<MODE>::DV, NQ = DQK / 16, ND = DV / 32, KROW = DQK * 2 + 16, SHM_K = 64 * KROW, SHM_V = 64 * DV * 2;
  int tid_ = threadIdx.x; asm volatile("" : "+v"(tid_));
  const int tid = tid_, wid = tid >> 6, lane = tid & 63, r32 = lane & 31, hi = lane >> 5;
  const lptr V_lds = lds + V_OFF, K_lds = lds + K_OFF;
  LAS float* ws = (LAS float*)(lds + WS_OFF) + wid * 64; LAS float* li_l = ws; LAS float* al_l = ws + 32;
  float m_reg = -1e30f, l_reg = 0.f;
#pragma unroll
  for (int d = 0; d < ND; ++d) o[d] = f32x16{};
  bf16x8 qr[NQ];
  { const bf16_t* Qw = A.Q0 + (size_t)(wid * 32 + r32) * A.ldq + hi * 8;
    if constexpr (MODE == 0) {
#pragma unroll
      for (int d0 = 0; d0 < 4; ++d0) qr[d0] = *(const bf16x8*)(Qw + d0 * 16);
      const bf16_t* Qw1 = A.Q1 + (size_t)(wid * 32 + r32) * A.ldq + hi * 8;
      qr[4] = *(const bf16x8*)(Qw1); qr[5] = *(const bf16x8*)(Qw1 + 16);
    } else {
#pragma unroll
      for (int d0 = 0; d0 < NQ; ++d0) qr[d0] = *(const bf16x8*)(Qw + d0 * 16);
    } }
  const int vb0 = (int)(uintptr_t)V_lds + v_rd_base(lane);
  Slot sr_[2];
  const int r8 = tid >> 3, c8 = (tid & 7) * 8;
  const int r16 = tid >> 4, c16 = (tid & 15) * 8;
  const int rr4 = (tid & 255) >> 2, cr4 = (tid & 3) * 8;
#define SLOAD(i, k0) do { \
    if constexpr (MODE == 0) { sr_[i].a = *(const bf16x8*)(A.K0 + (size_t)((k0) + r8) * A.ldk0 + c8); sr_[i].b = *(const bf16x8*)(A.K1 + (size_t)((k0) + rr4) * A.ldk1 + cr4); \
                               sr_[i].c = *(const bf16x8*)(A.V + (size_t)((k0) + r8) * A.ldv + c8); } \
    else if constexpr (MODE == 1) { sr_[i].a = *(const bf16x8*)(A.K0 + (size_t)((k0) + r8) * A.ldk0 + c8); \
                               sr_[i].c = *(const bf16x8*)(A.V + (size_t)((k0) + r16) * A.ldv + c16); sr_[i].d = *(const bf16x8*)(A.V + (size_t)((k0) + 32 + r16) * A.ldv + c16); } \
    else { sr_[i].a = *(const bf16x8*)(A.K0 + (size_t)((k0) + r16) * A.ldk0 + c16); sr_[i].b = *(const bf16x8*)(A.K0 + (size_t)((k0) + 32 + r16) * A.ldk0 + c16); \
           sr_[i].c = *(const bf16x8*)(A.V + (size_t)((k0) + r16) * A.ldv + c16); sr_[i].d = *(const bf16x8*)(A.V + (size_t)((k0) + 32 + r16) * A.ldv + c16); } } while (0)
#define SWRITE(bf, i) do { const lptr Kb = K_lds + (bf) * SHM_K; const lptr Vb = V_lds + (bf) * SHM_V; \
    if constexpr (MODE == 0) { *(LAS bf16x8*)(Kb + r8 * KROW + c8 * 2) = sr_[i].a; if (tid < 256) *(LAS bf16x8*)(Kb + rr4 * KROW + 128 + cr4 * 2) = sr_[i].b; \
                               *(LAS bf16x8*)(Vb + v_st<ND>(r8, c8)) = sr_[i].c; } \
    else if constexpr (MODE == 1) { *(LAS bf16x8*)(Kb + r8 * KROW + c8 * 2) = sr_[i].a; \
                               *(LAS bf16x8*)(Vb + v_st<ND>(r16, c16)) = sr_[i].c; *(LAS bf16x8*)(Vb + v_st<ND>(32 + r16, c16)) = sr_[i].d; } \
    else { *(LAS bf16x8*)(Kb + r16 * KROW + c16 * 2) = sr_[i].a; *(LAS bf16x8*)(Kb + (32 + r16) * KROW + c16 * 2) = sr_[i].b; \
           *(LAS bf16x8*)(Vb + v_st<ND>(r16, c16)) = sr_[i].c; *(LAS bf16x8*)(Vb + v_st<ND>(32 + r16, c16)) = sr_[i].d; } } while (0)
#define SWAIT() do { if constexpr (MODE == 2) asm volatile("s_waitcnt vmcnt(4)" ::: "memory"); else asm volatile("s_waitcnt vmcnt(3)" ::: "memory"); } while (0)
#define ATT_BAR() asm volatile("s_waitcnt lgkmcnt(0)\n\ts_barrier" ::: "memory")
#define RESC(a) do { if (__any((a) < 1.f)) { if (hi == 0) al_l[r32] = (a); asm volatile("s_waitcnt lgkmcnt(0)" ::: "memory"); \
    _Pragma("unroll") for (int d = 0; d < ND; ++d) _Pragma("unroll") for (int r = 0; r < 16; ++r) o[d][r] *= al_l[crow(r, hi)]; } } while (0)
  f32x16 pA0, pA1, pB0, pB1; float mnA, mnB, alA, alB; bf16x8 pa0, pa1, pa2, pa3; const int NT = A.nkeys / 64;
  const float C = A.C, thr = A.thr;
  SLOAD(0, 0); asm volatile("s_waitcnt vmcnt(0)" ::: "memory"); SWRITE(0, 0); ATT_BAR();
  qkt<NQ, KROW>(pA0, pA1, K_lds, qr, r32, hi); partialSM(pA0, pA1, m_reg, mnA, alA, C, thr);
  SLOAD(1, 64); if (2 < NT) SLOAD(0, 128);
  SWAIT(); SWRITE(1, 1); ATT_BAR();
  for (int j = 1; j + 1 < NT; j += 2) {
    SBAR(); qkt<NQ, KROW>(pB0, pB1, K_lds + SHM_K, qr, r32, hi);
    finishSM(pA0, pA1, alA, l_reg, pa0, pa1, pa2, pa3); SBAR();
    SLOAD(1, (j + 2) * 64); SBAR();
    pv_all<ND>(o, vb0, pa0, pa1, pa2, pa3); partialSM(pB0, pB1, m_reg, mnB, alB, C, thr);
    ATT_BAR(); SWAIT(); SWRITE(0, 0);
    RESC(alB); ATT_BAR();
    SBAR(); qkt<NQ, KROW>(pA0, pA1, K_lds, qr, r32, hi);
    finishSM(pB0, pB1, alB, l_reg, pa0, pa1, pa2, pa3); SBAR();
    if (j + 3 < NT) SLOAD(0, (j + 3) * 64); SBAR();
    pv_all<ND>(o, vb0 + SHM_V, pa0, pa1, pa2, pa3); partialSM(pA0, pA1, m_reg, mnA, alA, C, thr);
    ATT_BAR(); SWAIT(); SWRITE(1, 1);
    RESC(alA); ATT_BAR();
  }
  SBAR(); qkt<NQ, KROW>(pB0, pB1, K_lds + SHM_K, qr, r32, hi);
  finishSM(pA0, pA1, alA, l_reg, pa0, pa1, pa2, pa3); SBAR();
  pv_all<ND>(o, vb0, pa0, pa1, pa2, pa3); partialSM(pB0, pB1, m_reg, mnB, alB, C, thr);
  ATT_BAR(); RESC(alB);
  finishSM(pB0, pB1, alB, l_reg, pa0, pa1, pa2, pa3); SBAR();
  pv_all<ND>(o, vb0 + SHM_V, pa0, pa1, pa2, pa3);
  if (hi == 0) li_l[r32] = l_reg; asm volatile("s_waitcnt lgkmcnt(0)" ::: "memory");
#pragma unroll
  for (int r = 0; r < 16; ++r) rli[r] = __builtin_amdgcn_rcpf(li_l[crow(r, hi)]);
  ATT_BAR();
#undef SLOAD
#undef SWRITE
#undef SWAIT
#undef RESC
#undef ATT_BAR
}
}

typedef unsigned short bf16;
typedef float f32x4 __attribute__((ext_vector_type(4)));
typedef unsigned v4u __attribute__((ext_vector_type(4)));
constexpr int T = 32768, DM = 1024, SEQ = 2048, NBATCH = 16, DEPTH = 4, MEMLEN = 256, NIN = 7328, DFF = 4096;
constexpr int NWAVES = 8, NTHREADS = 512;
constexpr float ALPHA = 1.6817928305074290f;
constexpr int LDS_BYTES = 139264;
static_assert(att::ATT_LDS_END <= LDS_BYTES && pg8::STAGE_BYTES <= LDS_BYTES, "LDS map");
constexpr size_t MiB = 1u << 20;
constexpr size_t WS_BAR = 512 * 1024;
constexpr size_t WS_RSQ = 0, WS_RSKV = 256 * 1024;
constexpr size_t WS_COSM = 1 * MiB, WS_SINM = 3 * MiB, WS_COSD = 5 * MiB, WS_SIND = 6 * MiB;
constexpr size_t WS_W = 8 * MiB;
constexpr size_t WS_MEMB = 48 * MiB, WS_MEMKV = 56 * MiB, WS_XB = 64 * MiB;
constexpr size_t WS_DQ = 128 * MiB, WS_MQ = 192 * MiB, WS_QM = 224 * MiB, WS_LAT = 272 * MiB, WS_DK = 320 * MiB, WS_DV = 384 * MiB, WS_KVM = 448 * MiB, WS_END = 512 * MiB;
constexpr size_t WS_G = 272 * MiB, WS_MG = 336 * MiB;
constexpr size_t WS_HID = 128 * MiB;
constexpr size_t WO_IN = 0, WO_G = WO_IN + (size_t)4352 * 1024, WO_UQ = WO_G + (size_t)3072 * 1024, WO_UKV = WO_UQ + (size_t)768 * 384, WO_MKV = WO_UKV + (size_t)1024 * 256,
                 WO_BM = WO_MKV + (size_t)1024 * 1024, WO_BD = WO_BM + (size_t)1024 * 512, WO_BE = WO_BD + (size_t)1024 * 1024, WO_OUT = WO_BE + (size_t)1024 * 512,
                 WO_1 = WO_OUT + (size_t)1024 * 1024, WO_2 = WO_1 + (size_t)4096 * 1024, WO_END = WO_2 + (size_t)4096 * 1024;
static_assert(WO_END * 2 <= 40 * MiB, "weight copies fit");

struct Params {
    const float *x, *mem; const int* pos;
    const float *w_in, *b_gate, *q_norm, *kv_norm, *w_uq, *w_ukv, *dlam, *subln, *w_mkv, *w_br, *w_out, *ln1g, *ln1b, *w1, *w2, *ln2g, *ln2b;
    float* out; unsigned char* ws;
};
typedef const __attribute__((address_space(4))) Params* kparams_t;
__device__ __forceinline__ kparams_t getp() { kparams_t kp = (kparams_t)__builtin_amdgcn_kernarg_segment_ptr(); asm volatile("" : "+s"(kp)); return kp; }

#define LDS_WAIT() asm volatile("s_waitcnt lgkmcnt(0)" ::: "memory")
__device__ __forceinline__ unsigned f2bf_u(float f) { unsigned u = __builtin_bit_cast(unsigned, f); return (u + 0x7fffu + ((u >> 16) & 1u)) >> 16; }
__device__ __forceinline__ unsigned pk2(float lo, float hi) { return f2bf_u(lo) | (f2bf_u(hi) << 16); }
__device__ __forceinline__ float wave_sum(float v) {
#pragma unroll
    for (int o = 1; o < 64; o <<= 1) v += __shfl_xor(v, o);
    return v;
}

__device__ __forceinline__ void tr_item(const float* W, int ldw, int sc, int K, bf16* WT, int n0, int k0, const float* gain, LAS float* scr, int lane) {
    float vv[32];
#pragma unroll
    for (int i = 0; i < 32; ++i) { const int kk = 2 * i + (lane >> 5); vv[i] = (sc >= 0) ? W[(size_t)(k0 + kk) * ldw + sc + (lane & 31)] : 0.f; }
#pragma unroll
    for (int i = 0; i < 32; ++i) { const int kk = 2 * i + (lane >> 5); float v = vv[i]; if (sc >= 0 && gain) v *= gain[k0 + kk]; scr[kk * 33 + (lane & 31)] = v; }
    LDS_WAIT(); asm volatile("" ::: "memory");
    const int c = lane & 7;
#pragma unroll
    for (int j = 0; j < 4; ++j) { const int n = (lane >> 3) + 8 * j; const LAS float* s = scr + (8 * c) * 33 + n;
        v4u o; o.x = pk2(s[0 * 33], s[1 * 33]); o.y = pk2(s[2 * 33], s[3 * 33]); o.z = pk2(s[4 * 33], s[5 * 33]); o.w = pk2(s[6 * 33], s[7 * 33]);
        *(v4u*)(WT + (size_t)(n0 + n) * K + k0 + 8 * c) = o; }
    LDS_WAIT(); asm volatile("" ::: "memory");
}
__device__ __forceinline__ bool tr_job(int& it, const float* W, int ldw, int K, int N, bf16* WT, int kind, int coff, const float* gain, LAS float* scr, int lane) {
    const int nblk = N / 32, items = (K / 64) * nblk;
    if (it >= items) { it -= items; return false; }
    const int kb = it / nblk, nb = it % nblk, n0 = 32 * nb; int sc;
    if (kind == 0) sc = n0 + coff;
    else if (kind == 1) sc = (n0 < 672) ? n0 : (n0 < 768 ? -1 : n0 - 96);
    else sc = (n0 < 512) ? (n0 >> 6) * 96 + (n0 & 63) : ((n0 - 512) >> 5) * 96 + 64;
    tr_item(W, ldw, sc, K, WT, n0, 64 * kb, gain, scr, lane);
    return true;
}
__device__ __forceinline__ void convert_weights(int l, LAS unsigned char* lds, int gw, int NGW, int wave, int lane_) {
    int lane = lane_; asm volatile("" : "+v"(lane)); const kparams_t kp = getp();
    LAS float* scr = (LAS float*)(lds + wave * 16384);
    bf16* Wb = (bf16*)(kp->ws + WS_W);
    const float* w_in = kp->w_in + (size_t)l * DM * NIN; const float* wbr = kp->w_br + (size_t)l * 2048 * 1024;
    constexpr int NITEMS = 16 * 136 + 16 * 96 + 6 * 24 + 4 * 32 + 16 * 32 + 8 * 32 + 16 * 32 + 8 * 32 + 16 * 32 + 16 * 128 + 64 * 32;
    for (int item = gw; item < NITEMS; item += NGW) {
        int it = item;
        if (tr_job(it, w_in, NIN, 1024, 4352, Wb + WO_IN, 1, 0, nullptr, scr, lane)) continue;
        if (tr_job(it, w_in, NIN, 1024, 3072, Wb + WO_G, 0, 4256, nullptr, scr, lane)) continue;
        if (tr_job(it, kp->w_uq + (size_t)l * 384 * 768, 768, 384, 768, Wb + WO_UQ, 2, 0, kp->q_norm + l * 384, scr, lane)) continue;
        if (tr_job(it, kp->w_ukv + (size_t)l * 256 * 1024, 1024, 256, 1024, Wb + WO_UKV, 0, 0, kp->kv_norm + l * 256, scr, lane)) continue;
        if (tr_job(it, kp->w_mkv + (size_t)l * 1024 * 1024, 1024, 1024, 1024, Wb + WO_MKV, 0, 0, nullptr, scr, lane)) continue;
        if (tr_job(it, wbr, 1024, 512, 1024, Wb + WO_BM, 0, 0, nullptr, scr, lane)) continue;
        if (tr_job(it, wbr + (size_t)512 * 1024, 1024, 1024, 1024, Wb + WO_BD, 0, 0, nullptr, scr, lane)) continue;
        if (tr_job(it, wbr + (size_t)1536 * 1024, 1024, 512, 1024, Wb + WO_BE, 0, 0, nullptr, scr, lane)) continue;
        if (tr_job(it, kp->w_out + (size_t)l * 1024 * 1024, 1024, 1024, 1024, Wb + WO_OUT, 0, 0, nullptr, scr, lane)) continue;
        if (tr_job(it, kp->w1 + (size_t)l * 1024 * 4096, 4096, 1024, 4096, Wb + WO_1, 0, 0, nullptr, scr, lane)) continue;
        tr_job(it, kp->w2 + (size_t)l * 4096 * 1024, 1024, 4096, 1024, Wb + WO_2, 0, 0, nullptr, scr, lane);
    }
}
__device__ __forceinline__ void ln_rows(float* X, bf16* XB, const float* g, const float* b, int gw, int NGW, int lane_, int row_end = T) {
    int lane = lane_; asm volatile("" : "+v"(lane));
    f32x4 gv[4], bv[4];
#pragma unroll
    for (int j = 0; j < 4; ++j) { gv[j] = ((const f32x4*)g)[lane + 64 * j]; bv[j] = ((const f32x4*)b)[lane + 64 * j]; }
    for (int m = gw; m < row_end; m += 2 * NGW) {
        const int m2 = (m + NGW < row_end) ? m + NGW : m;
        f32x4* xr = (f32x4*)(X + (size_t)m * DM) + lane; f32x4* xr2 = (f32x4*)(X + (size_t)m2 * DM) + lane; f32x4 v[4], w[4]; float s = 0.f, t = 0.f;
#pragma unroll
        for (int j = 0; j < 4; ++j) { v[j] = xr[64 * j]; w[j] = xr2[64 * j]; }
#pragma unroll
        for (int j = 0; j < 4; ++j) { s += (v[j].x + v[j].y) + (v[j].z + v[j].w); t += (w[j].x + w[j].y) + (w[j].z + w[j].w); }
        const float mean = wave_sum(s) * (1.f / DM), mean2 = wave_sum(t) * (1.f / DM); float s2 = 0.f, t2 = 0.f;
#pragma unroll
        for (int j = 0; j < 4; ++j) { v[j] = v[j] - mean; s2 += (v[j].x * v[j].x + v[j].y * v[j].y) + (v[j].z * v[j].z + v[j].w * v[j].w);
                                      w[j] = w[j] - mean2; t2 += (w[j].x * w[j].x + w[j].y * w[j].y) + (w[j].z * w[j].z + w[j].w * w[j].w); }
        const float rstd = 1.f / sqrtf(wave_sum(s2) * (1.f / DM) + 1e-5f), rstd2 = 1.f / sqrtf(wave_sum(t2) * (1.f / DM) + 1e-5f);
        unsigned long long* o8 = (unsigned long long*)(XB + (size_t)m * DM) + lane; unsigned long long* o82 = (unsigned long long*)(XB + (size_t)m2 * DM) + lane;
#pragma unroll
        for (int j = 0; j < 4; ++j) { const f32x4 y = v[j] * rstd * gv[j] + bv[j]; xr[64 * j] = y;
            o8[64 * j] = (unsigned long long)pk2(y.x, y.y) | ((unsigned long long)pk2(y.z, y.w) << 32); }
        if (m2 != m) {
#pragma unroll
        for (int j = 0; j < 4; ++j) { const f32x4 y = w[j] * rstd2 * gv[j] + bv[j]; xr2[64 * j] = y;
            o82[64 * j] = (unsigned long long)pk2(y.x, y.y) | ((unsigned long long)pk2(y.z, y.w) << 32); } }
    }
}
__device__ __forceinline__ void rowscale_rows(const bf16* lat, float* rsq, float* rskv, int gw, int NGW, int lane_) {
    int lane = lane_; asm volatile("" : "+v"(lane));
    for (int row = gw; row < T; row += 4 * NGW) {
        unsigned w[4][5];
#pragma unroll
        for (int q = 0; q < 4; ++q) { const unsigned* src = (const unsigned*)(lat + (size_t)(row + q * NGW) * 768) + lane;
#pragma unroll
            for (int k = 0; k < 5; ++k) w[q][k] = src[64 * k]; }
#pragma unroll
        for (int q = 0; q < 4; ++q) { float sq = 0.f, sk = 0.f;
#pragma unroll
            for (int k = 0; k < 5; ++k) { const float a = __uint_as_float(w[q][k] << 16), b = __uint_as_float(w[q][k] & 0xffff0000u); if (k < 3) sq += a * a + b * b; else sk += a * a + b * b; }
            sq = wave_sum(sq); sk = wave_sum(sk);
            if (lane == 0) { rsq[row + q * NGW] = 1.0f / sqrtf(sq * (1.f / 384.f) + 1e-6f); rskv[row + q * NGW] = 1.0f / sqrtf(sk * (1.f / 256.f) + 1e-6f); } }
    }
}

#ifndef PH_MASK
#define PH_MASK 0xffff
#endif

#define WSP(T_, off) ((T_*)(ws + (off)))
__device__ __forceinline__ void grid_barrier(unsigned* cnt, unsigned target) {
    asm volatile("s_waitcnt vmcnt(0) lgkmcnt(0)" ::: "memory");
    __syncthreads();
    if (threadIdx.x == 0) {
        __builtin_amdgcn_fence(__ATOMIC_RELEASE, "agent");
        asm volatile("s_waitcnt vmcnt(0)" ::: "memory");
        __hip_atomic_fetch_add(cnt, 1u, __ATOMIC_RELAXED, __HIP_MEMORY_SCOPE_AGENT);
        while (__hip_atomic_load(cnt, __ATOMIC_RELAXED, __HIP_MEMORY_SCOPE_AGENT) < target) __builtin_amdgcn_s_sleep(2);
        __builtin_amdgcn_fence(__ATOMIC_ACQUIRE, "agent");
        asm volatile("s_waitcnt vmcnt(0)" ::: "memory");
    }
    __syncthreads();
}
#define GRID_SYNC() do { nsync += (unsigned)G; grid_barrier(bar_cnt, nsync); } while (0)
__global__ void __launch_bounds__(NTHREADS, 2) fwd_megakernel(Params p_unused) {
    extern __shared__ __attribute__((aligned(16))) unsigned char lds_raw[];
    cg::grid_group grid = cg::this_grid();
    LAS unsigned char* lds = (LAS unsigned char*)lds_raw;
    const int tid = threadIdx.x, lane = tid & 63, wave = __builtin_amdgcn_readfirstlane(tid >> 6);
    const int G = gridDim.x, bx = blockIdx.x;
    const int vcu = (G % 8 == 0) ? (bx % 8) * (G / 8) + bx / 8 : bx;
    const int gw = vcu * NWAVES + wave, NGW = G * NWAVES;
    unsigned nsync = 0u; unsigned* bar_cnt = (unsigned*)(getp()->ws + WS_BAR);
    grid.sync();

#if (PH_MASK & 1)
    {   const kparams_t kp = getp(); unsigned char* ws = kp->ws; float* X = kp->out; const float* xin = kp->x; const float* memin = kp->mem; const int* pos = kp->pos;
        bf16 *XB = WSP(bf16, WS_XB), *MEMB = WSP(bf16, WS_MEMB);
        float *COSM = WSP(float, WS_COSM), *SINM = WSP(float, WS_SINM), *COSD = WSP(float, WS_COSD), *SIND = WSP(float, WS_SIND);
        const long gt = (long)bx * NTHREADS + tid, NGT = (long)G * NTHREADS;
        for (long i = gt; i < (long)T * DM / 4; i += 4 * NGT) { f32x4 v[4];
#pragma unroll
            for (int q = 0; q < 4; ++q) v[q] = ((const f32x4*)xin)[i + q * NGT];
#pragma unroll
            for (int q = 0; q < 4; ++q) { ((f32x4*)X)[i + q * NGT] = v[q];
                ((unsigned long long*)XB)[i + q * NGT] = (unsigned long long)pk2(v[q].x, v[q].y) | ((unsigned long long)pk2(v[q].z, v[q].w) << 32); } }
        for (long i = gt; i < (long)NBATCH * MEMLEN * DM / 4; i += NGT) { const f32x4 v = ((const f32x4*)memin)[i];
            ((unsigned long long*)MEMB)[i] = (unsigned long long)pk2(v.x, v.y) | ((unsigned long long)pk2(v.z, v.w) << 32); }
        for (long i = gt; i < (long)T * 16; i += NGT) { const int t = (int)(i >> 4), j = (int)(i & 15); const float inv = exp2f(-(float)(2 * j) * (18.931568569324174f / 32.f)); const float ang = (float)pos[t] * inv;
            const double a = (double)ang, n = rint(a * 0.15915494309189535), r = a - n * 6.283185307179586;
            COSM[i] = (float)cos(r); SINM[i] = (float)sin(r); }
        for (long i = gt; i < (long)T * 8; i += NGT) { const int t = (int)(i >> 3), j = (int)(i & 7); const float inv = exp2f(-(float)(2 * j) * (18.931568569324174f / 16.f)); const float ang = (float)pos[t] * inv;
            const double a = (double)ang, n = rint(a * 0.15915494309189535), r = a - n * 6.283185307179586;
            COSD[i] = (float)cos(r); SIND[i] = (float)sin(r); }
        convert_weights(0, lds, gw, NGW, wave, lane);
    }
    GRID_SYNC();
#endif

    for (int l = 0; l < DEPTH; ++l) {
        const float lambda_init = 0.8f - 0.6f * __expf(-0.3f * (float)l);
#if (PH_MASK & 2)
        {   const kparams_t kp = getp(); unsigned char* ws = kp->ws; bf16* Wb = WSP(bf16, WS_W);
            {   pg8::Gemm g{WSP(bf16, WS_XB), Wb + WO_IN, T, 4352, 1024, 1024, 1024}; pg8::StaticOrder S; S.init(T, 4352, G, bx);
                pg8::EpiH E{WSP(bf16, WS_LAT), WSP(bf16, WS_DQ), WSP(bf16, WS_DK), WSP(bf16, WS_DV), WSP(bf16, WS_MQ), WSP(float, WS_COSD), WSP(float, WS_SIND), WSP(float, WS_COSM), WSP(float, WS_SINM)};
                pg8::gemm_phase<pg8::EpiH, pg8::StaticOrder, true, true>(lds, g, S, E); }
            {   pg8::Gemm g{WSP(bf16, WS_MEMB), Wb + WO_MKV, NBATCH * MEMLEN, 1024, 1024, 1024, 1024}; pg8::StaticOrder S; S.init(NBATCH * MEMLEN, 1024, G, (bx + G / 2) % G);
                pg8::EpiScale<false> E{WSP(bf16, WS_MEMKV), 1024, nullptr, nullptr, nullptr};
                pg8::gemm_phase<pg8::EpiScale<false>, pg8::StaticOrder, true, true>(lds, g, S, E); } }
        GRID_SYNC();
#endif
#if (PH_MASK & 4)
        {   const kparams_t kp = getp(); unsigned char* ws = kp->ws; bf16* Wb = WSP(bf16, WS_W); bf16* LAT = WSP(bf16, WS_LAT); float *RSQ = WSP(float, WS_RSQ), *RSKV = WSP(float, WS_RSKV);
            rowscale_rows(LAT, RSQ, RSKV, gw, NGW, lane);
            GRID_SYNC();
            pg8::StaticOrder Sq; Sq.init(T, 768, G, bx); pg8::StaticOrder Skv; Skv.init(T, 1024, G, bx);
            {   pg8::Gemm g{LAT, Wb + WO_UQ, T, 768, 384, 768, 384}; pg8::EpiScale<true> E{WSP(bf16, WS_QM), 768, RSQ, WSP(float, WS_COSM), WSP(float, WS_SINM)};
                pg8::gemm_phase<pg8::EpiScale<true>, pg8::StaticOrder, true, true>(lds, g, Sq, E); }
            {   pg8::Gemm g{LAT + 384, Wb + WO_UKV, T, 1024, 256, 768, 256}; pg8::EpiScale<false> E{WSP(bf16, WS_KVM), 1024, RSKV, nullptr, nullptr};
                pg8::gemm_phase<pg8::EpiScale<false>, pg8::StaticOrder, true, true>(lds, g, Skv, E); } }
        GRID_SYNC();
#endif
        {
            const att::lptr alds = (att::lptr)lds;
            { const int rep = 1;
            int lane_a = lane; asm volatile("" : "+v"(lane_a)); const int r32 = lane_a & 31, hi = lane_a >> 5;
#if (PH_MASK & 8)
            {   const kparams_t kp = getp(); unsigned char* ws = kp->ws; bf16 *DQ = WSP(bf16, WS_DQ), *DK = WSP(bf16, WS_DK), *DV = WSP(bf16, WS_DV);
                float lam;
                {   const float* dl = kp->dlam + (size_t)l * 256; const float a = wave_sum(dl[lane_a] * dl[64 + lane_a]), b2 = wave_sum(dl[128 + lane_a] * dl[192 + lane_a]);
                    lam = __expf(a) - __expf(b2) + lambda_init; }
                const float* subln = kp->subln + l * 128;
                for (int idx = vcu; idx < NBATCH * 8 * 8; idx += G) {
                    const int bh = idx >> 3, qb = idx & 7, b = bh >> 3, h = bh & 7; const size_t row0 = (size_t)b * SEQ + qb * 256, key0 = (size_t)b * SEQ;
                    att::f32x16 o[4]; float rli[16];
                    att::Args A; A.ldq = 1024; A.ldk0 = 1024; A.ldk1 = 0; A.ldv = 1024; A.nkeys = SEQ; A.C = 0.125f * 1.4426950408889634f; A.thr = 8.f / 0.125f; A.Q1 = nullptr; A.K1 = nullptr;
                    A.Q0 = DQ + row0 * 1024 + h * 128; A.K0 = DK + key0 * 1024 + h * 128; A.V = DV + key0 * 1024 + h * 128;
                    att::attn_core<1>(A, alds, o, rli);
                    int ls = lane_a; asm volatile("" : "+v"(ls)); LAS unsigned* stash = (LAS unsigned*)(lds + att::STASH_OFF) + wave * 2048 + ls;
#pragma unroll
                    for (int d = 0; d < 4; ++d)
#pragma unroll
                        for (int j = 0; j < 8; ++j) stash[(d * 8 + j) * 64] = att::cvtpk(o[d][2 * j] * rli[2 * j], o[d][2 * j + 1] * rli[2 * j + 1]);
                    A.Q0 += 64; A.K0 += 64;
                    att::attn_core<1>(A, alds, o, rli);
                    float ss[16];
#pragma unroll
                    for (int r = 0; r < 16; ++r) ss[r] = 0.f;
#pragma unroll
                    for (int d = 0; d < 4; ++d)
#pragma unroll
                        for (int j = 0; j < 8; ++j) { const unsigned w = stash[(d * 8 + j) * 64];
                            const float d0v = __uint_as_float(w << 16) - lam * (o[d][2 * j] * rli[2 * j]), d1v = __uint_as_float(w & 0xffff0000u) - lam * (o[d][2 * j + 1] * rli[2 * j + 1]);
                            o[d][2 * j] = d0v; o[d][2 * j + 1] = d1v; ss[2 * j] += d0v * d0v; ss[2 * j + 1] += d1v * d1v; }
#pragma unroll
                    for (int r = 0; r < 16; ++r) { float s = ss[r]; s += __shfl_xor(s, 1); s += __shfl_xor(s, 2); s += __shfl_xor(s, 4); s += __shfl_xor(s, 8); s += __shfl_xor(s, 16);
                        ss[r] = (1.0f / sqrtf(s * (1.f / 128.f) + 1e-5f)) * (1.f - lambda_init); }
                    int lq = lane_a; asm volatile("" : "+v"(lq));
                    bf16* Ob = DQ + (row0 + wave * 32 + 4 * (lq >> 5)) * 1024 + h * 128 + (lq & 31);
#pragma unroll
                    for (int d = 0; d < 4; ++d) { const float gsub = subln[d * 32 + (lq & 31)];
#pragma unroll
                        for (int r = 0; r < 16; ++r) if (rep) Ob[att::crow(r, 0) * 1024 + d * 32] = att::f2bf(o[d][r] * ss[r] * gsub); }
                } }
#endif
#if (PH_MASK & 16)
            {   const kparams_t kp = getp(); unsigned char* ws = kp->ws; bf16 *QM = WSP(bf16, WS_QM), *KVM = WSP(bf16, WS_KVM), *LAT = WSP(bf16, WS_LAT);
                for (int idx = vcu; idx < NBATCH * 8 * 8; idx += G) {
                    const int bh = idx >> 3, qb = idx & 7, b = bh >> 3, h = bh & 7; const size_t row0 = (size_t)b * SEQ + qb * 256, key0 = (size_t)b * SEQ;
                    att::f32x16 o[2]; float rli[16];
                    att::Args A; A.ldq = 768; A.ldk0 = 1024; A.ldk1 = 768; A.ldv = 1024; A.nkeys = SEQ; A.C = 0.10206207261596575f * 1.4426950408889634f; A.thr = 8.f / 0.10206207261596575f;
                    A.Q0 = QM + row0 * 768 + h * 64; A.Q1 = QM + row0 * 768 + 512 + h * 32; A.K0 = KVM + key0 * 1024 + h * 128; A.K1 = LAT + key0 * 768 + 640; A.V = KVM + key0 * 1024 + h * 128 + 64;
                    att::attn_core<0>(A, alds, o, rli);
                    int lq = lane_a; asm volatile("" : "+v"(lq));
                    bf16* Ob = QM + (row0 + wave * 32 + 4 * (lq >> 5)) * 768 + h * 64 + (lq & 31);
#pragma unroll
                    for (int d = 0; d < 2; ++d)
#pragma unroll
                        for (int r = 0; r < 16; ++r) if (rep) Ob[att::crow(r, 0) * 768 + d * 32] = att::f2bf(o[d][r] * rli[r]);
                } }
#endif
#if (PH_MASK & 32)
            {   const kparams_t kp = getp(); unsigned char* ws = kp->ws; bf16 *MQ = WSP(bf16, WS_MQ), *MEMKV = WSP(bf16, WS_MEMKV);
                for (int idx = vcu; idx < NBATCH * 4 * 8; idx += G) {
                    const int bh = idx >> 3, qb = idx & 7, b = bh >> 2, h = bh & 3; const size_t row0 = (size_t)b * SEQ + qb * 256, key0 = (size_t)b * MEMLEN;
                    att::f32x16 o[4]; float rli[16];
                    att::Args A; A.ldq = 512; A.ldk0 = 1024; A.ldk1 = 0; A.ldv = 1024; A.nkeys = MEMLEN; A.C = 0.08838834764831845f * 1.4426950408889634f; A.thr = 8.f / 0.08838834764831845f; A.Q1 = nullptr; A.K1 = nullptr;
                    A.Q0 = MQ + row0 * 512 + h * 128; A.K0 = MEMKV + key0 * 1024 + h * 128; A.V = MEMKV + key0 * 1024 + 512 + h * 128;
                    att::attn_core<2>(A, alds, o, rli);
                    int lq = lane_a; asm volatile("" : "+v"(lq));
                    bf16* Ob = MQ + (row0 + wave * 32 + 4 * (lq >> 5)) * 512 + h * 128 + (lq & 31);
#pragma unroll
                    for (int d = 0; d < 4; ++d)
#pragma unroll
                        for (int r = 0; r < 16; ++r) if (rep) Ob[att::crow(r, 0) * 512 + d * 32] = att::f2bf(o[d][r] * rli[r]);
                } }
#endif
            }
        }
        GRID_SYNC();
#if (PH_MASK & 64)
        {   const kparams_t kp = getp(); unsigned char* ws = kp->ws; bf16* Wb = WSP(bf16, WS_W); bf16 *XB = WSP(bf16, WS_XB), *GB = WSP(bf16, WS_G), *MG = WSP(bf16, WS_MG);
            pg8::StaticOrder S; S.init(T, 1024, G, bx); const float* bg = kp->b_gate + (size_t)l * 3 * 1024;
            {
            {   pg8::Gemm g{XB, Wb + WO_G, T, 1024, 1024, 1024, 1024}; pg8::EpiGate E{GB, bg};
                pg8::gemm_phase<pg8::EpiGate, pg8::StaticOrder, true, true>(lds, g, S, E); }
            {   pg8::Gemm g{WSP(bf16, WS_QM), Wb + WO_BM, T, 1024, 512, 768, 512}; pg8::EpiBranch<true> E{GB, MG};
                pg8::gemm_phase<pg8::EpiBranch<true>, pg8::StaticOrder, true, true>(lds, g, S, E); }
            {   pg8::Gemm g{XB, Wb + WO_G + (size_t)1024 * 1024, T, 1024, 1024, 1024, 1024}; pg8::EpiGate E{GB, bg + 1024};
                pg8::gemm_phase<pg8::EpiGate, pg8::StaticOrder, true, true>(lds, g, S, E); }
            {   pg8::Gemm g{WSP(bf16, WS_DQ), Wb + WO_BD, T, 1024, 1024, 1024, 1024}; pg8::EpiBranch<false> E{GB, MG};
                pg8::gemm_phase<pg8::EpiBranch<false>, pg8::StaticOrder, true, true>(lds, g, S, E); }
            {   pg8::Gemm g{XB, Wb + WO_G + (size_t)2048 * 1024, T, 1024, 1024, 1024, 1024}; pg8::EpiGate E{GB, bg + 2048};
                pg8::gemm_phase<pg8::EpiGate, pg8::StaticOrder, true, true>(lds, g, S, E); }
            {   pg8::Gemm g{WSP(bf16, WS_MQ), Wb + WO_BE, T, 1024, 512, 512, 512}; pg8::EpiBranch<false> E{GB, MG};
                pg8::gemm_phase<pg8::EpiBranch<false>, pg8::StaticOrder, true, true>(lds, g, S, E); } } }
        GRID_SYNC();
#endif
#if (PH_MASK & 128)
        {   const kparams_t kp = getp(); unsigned char* ws = kp->ws;
            pg8::Gemm g{WSP(bf16, WS_MG), WSP(bf16, WS_W) + WO_OUT, T, 1024, 1024, 1024, 1024}; pg8::StaticOrder S; S.init(T, 1024, G, bx); pg8::EpiRes E{kp->out, ALPHA};
            pg8::gemm_phase<pg8::EpiRes, pg8::StaticOrder, true, true>(lds, g, S, E); }
        GRID_SYNC();
#endif
        {   const kparams_t kp = getp(); unsigned char* ws = kp->ws;
            ln_rows(kp->out, WSP(bf16, WS_XB), kp->ln1g + l * DM, kp->ln1b + l * DM, gw, NGW, lane); }
        GRID_SYNC();
#if (PH_MASK & 256)
        {   const kparams_t kp = getp(); unsigned char* ws = kp->ws;
            pg8::Gemm g{WSP(bf16, WS_XB), WSP(bf16, WS_W) + WO_1, T, 4096, 1024, 1024, 1024}; pg8::StaticOrder S; S.init(T, 4096, G, bx); pg8::EpiRelu2 E{WSP(bf16, WS_HID), 4096};
            pg8::gemm_phase<pg8::EpiRelu2, pg8::StaticOrder, true, true>(lds, g, S, E); }
        GRID_SYNC();
#endif
#if (PH_MASK & 512)
        {   const kparams_t kp = getp(); unsigned char* ws = kp->ws;
            pg8::Gemm g{WSP(bf16, WS_HID), WSP(bf16, WS_W) + WO_2, T, 1024, 4096, 4096, 4096}; pg8::StaticOrder S; S.init(T, 1024, G, bx); pg8::EpiRes E{kp->out, ALPHA};
            pg8::gemm_phase<pg8::EpiRes, pg8::StaticOrder, true, true>(lds, g, S, E); }
        GRID_SYNC();
#endif
        {   const kparams_t kp = getp(); unsigned char* ws = kp->ws;
            ln_rows(kp->out, WSP(bf16, WS_XB), kp->ln2g + l * DM, kp->ln2b + l * DM, gw, NGW, lane); }
        if (l + 1 < DEPTH) { convert_weights(l + 1, lds, gw, NGW, wave, lane); GRID_SYNC(); }
    }
}

extern "C" void kernel_launch(void* const* d_in, const int* in_sizes, int n_in, void* d_out, int out_size, void* d_ws, size_t ws_size, hipStream_t stream) {
    static int grid = 0;
    if (grid == 0) {
        if (n_in != 20 || in_sizes[0] != T * DM || out_size != T * DM || ws_size < WS_END) {
            fprintf(stderr, "kernel_launch: unexpected shapes (n_in %d, in0 %d, out %d, ws %zu; need ws >= %zu); nothing launched\n", n_in, n_in > 0 ? in_sizes[0] : -1, out_size, ws_size, (size_t)WS_END); grid = -1; return; }
        int dev = 0, cus = 0, per_cu = 0;
        if (hipGetDevice(&dev) != hipSuccess || hipDeviceGetAttribute(&cus, hipDeviceAttributeMultiprocessorCount, dev) != hipSuccess) { grid = -1; return; }
        if (hipFuncSetAttribute((const void*)fwd_megakernel, hipFuncAttributeMaxDynamicSharedMemorySize, LDS_BYTES) != hipSuccess) { fprintf(stderr, "kernel_launch: hipFuncSetAttribute failed\n"); grid = -1; return; }
        if (hipOccupancyMaxActiveBlocksPerMultiprocessor(&per_cu, (const void*)fwd_megakernel, NTHREADS, LDS_BYTES) != hipSuccess || per_cu < 1) { fprintf(stderr, "kernel_launch: occupancy query says %d\n", per_cu); per_cu = 1; }
        (void)hipGetLastError();
        grid = cus * 1;
    }
    if (grid < 0) return;
    if (hipMemsetAsync((char*)d_ws + WS_BAR, 0, 256, stream) != hipSuccess) { fprintf(stderr, "kernel_launch: hipMemsetAsync failed\n"); return; }
    Params p{};
    p.x = (const float*)d_in[0]; p.mem = (const float*)d_in[1]; p.pos = (const int*)d_in[2];
    p.w_in = (const float*)d_in[3]; p.b_gate = (const float*)d_in[4]; p.q_norm = (const float*)d_in[5]; p.kv_norm = (const float*)d_in[6];
    p.w_uq = (const float*)d_in[7]; p.w_ukv = (const float*)d_in[8]; p.dlam = (const float*)d_in[9]; p.subln = (const float*)d_in[10];
    p.w_mkv = (const float*)d_in[11]; p.w_br = (const float*)d_in[12]; p.w_out = (const float*)d_in[13]; p.ln1g = (const float*)d_in[14]; p.ln1b = (const float*)d_in[15];
    p.w1 = (const float*)d_in[16]; p.w2 = (const float*)d_in[17]; p.ln2g = (const float*)d_in[18]; p.ln2b = (const float*)d_in[19];
    p.out = (float*)d_out; p.ws = (unsigned char*)d_ws;
    void* args[] = {&p};
    hipError_t e = hipLaunchCooperativeKernel((const void*)fwd_megakernel, dim3(grid), dim3(NTHREADS), args, LDS_BYTES, stream);
    if (e != hipSuccess) fprintf(stderr, "kernel_launch: cooperative launch failed: %s (grid %d)\n", hipGetErrorString(e), grid);
}
```

```cpp
#include <hip/hip_runtime.h>
#include <hip/hip_cooperative_groups.h>
#include <cstdio>
#include <cstdint>
#include <cmath>
namespace cg = cooperative_groups;

namespace pg8 {
#define PG8_LAS __attribute__((address_space(3)))
typedef unsigned short bf16_t;
typedef short bf16x8 __attribute__((ext_vector_type(8)));
typedef float f32x4 __attribute__((ext_vector_type(4)));
typedef unsigned u32x4 __attribute__((ext_vector_type(4)));
constexpr int BM = 256, BK = 64, HALF = 128, HTB = HALF * BK * 2  , STAGE_BYTES = 8 * HTB, NXCD = 8, WGM = 8;

__host__ __device__ __forceinline__ int lds_byte(int r, int c) { const int st = (r >> 4) * 2 + (c >> 5), rr = r & 15, cc = c & 31, ob = rr * 64 + cc * 2; return st * 1024 + (ob ^ (((ob >> 9) & 1) << 5)); }
__host__ __device__ __forceinline__ void stage_rc(int b, int& R, int& C) { const int st = b / 1024, sb = b % 1024, swz = sb ^ (((sb >> 9) & 1) << 5); R = (st >> 1) * 16 + swz / 64; C = (st & 1) * 32 + (swz % 64) / 2; }
__host__ __device__ __forceinline__ int perm32(int rho) { const int n = rho >> 4, i = rho & 15; return 8 * (i >> 2) + 4 * n + (i & 3); }

struct Unit { int pm, pn; };
struct Gemm { const bf16_t* A; const bf16_t* Bt; int M, N, K, lda, ldb; };

struct StaticOrder {
    int nM, nN, nwg, G, c;
    __host__ __device__ void init(int M, int N, int G_, int c_) { nM = M / BM; nN = N / BM; nwg = nM * nN; G = G_; c = c_; }
    __host__ __device__ bool next(int i, Unit& u) const {
        const long L = (long)i * G + c; if (L >= nwg) return false;
        int wgid = (int)L; { const int q = nwg / NXCD, r = nwg % NXCD, xcd = wgid % NXCD, off = wgid / NXCD; wgid = (xcd < r ? xcd * (q + 1) : r * (q + 1) + (xcd - r) * q) + off; }
        const int nig = WGM * nN, gid = wgid / nig, fm = gid * WGM, gsz = (nM - fm) < WGM ? (nM - fm) : WGM;
        u.pm = fm + ((wgid % nig) % gsz); u.pn = (wgid % nig) / gsz; return true;
    }
    __device__ __forceinline__ void a_ready(const Unit&) const {}
    __device__ __forceinline__ void done(const Unit&) const {}
};

__device__ __forceinline__ unsigned cvt_pk_bf16(float lo, float hi) { unsigned r; asm volatile("v_cvt_pk_bf16_f32 %0, %1, %2" : "=v"(r) : "v"(lo), "v"(hi)); return r; }
__device__ __forceinline__ u32x4 pack8(const f32x4 v0, const f32x4 v1) { u32x4 w; w.x = cvt_pk_bf16(v0[0], v0[1]); w.y = cvt_pk_bf16(v0[2], v0[3]); w.z = cvt_pk_bf16(v1[0], v1[1]); w.w = cvt_pk_bf16(v1[2], v1[3]); return w; }
__device__ __forceinline__ u32x4 ld16_l2(const bf16_t* p) { const unsigned long long* q = (const unsigned long long*)p; const unsigned long long a = __hip_atomic_load(q, __ATOMIC_RELAXED, __HIP_MEMORY_SCOPE_AGENT), b = __hip_atomic_load(q + 1, __ATOMIC_RELAXED, __HIP_MEMORY_SCOPE_AGENT);
    u32x4 r; r.x = (unsigned)a; r.y = (unsigned)(a >> 32); r.z = (unsigned)b; r.w = (unsigned)(b >> 32); return r; }
__device__ __forceinline__ void st16(void* p, const u32x4 w) { unsigned long long* q = (unsigned long long*)p;
    __hip_atomic_store(q, (unsigned long long)w.x | ((unsigned long long)w.y << 32), __ATOMIC_RELAXED, __HIP_MEMORY_SCOPE_SYSTEM);
    __hip_atomic_store(q + 1, (unsigned long long)w.z | ((unsigned long long)w.w << 32), __ATOMIC_RELAXED, __HIP_MEMORY_SCOPE_SYSTEM); }
__device__ __forceinline__ float sgm(float v) { return __builtin_amdgcn_rcpf(1.f + __expf(-v)); }
__device__ __forceinline__ float bflo(unsigned w) { return __uint_as_float(w << 16); }
__device__ __forceinline__ float bfhi(unsigned w) { return __uint_as_float(w & 0xffff0000u); }
__device__ __forceinline__ f32x4 shx4(const f32x4 v, int m) { f32x4 r; r[0] = __shfl_xor(v[0], m); r[1] = __shfl_xor(v[1], m); r[2] = __shfl_xor(v[2], m); r[3] = __shfl_xor(v[3], m); return r; }

struct EpiH {
    static constexpr bool PERM = true, AFTER_DRAIN = false;
    bf16_t *lat, *dq, *dk, *dv, *mq; const float *cosd, *sind, *cosm, *sinm;
    __device__ __forceinline__ void operator()(const f32x4 (&acc)[2][2][4][2], const Unit& u, int wr, int wc, int fr, int fq) const {
        const int pn = u.pn; bf16_t* base; int ld, c0, mode;
        if (pn < 3) { base = lat; ld = 768; c0 = pn * 256; mode = (pn == 2) ? 2 : 0; }
        else if (pn < 7) { base = dq; ld = 1024; c0 = (pn - 3) * 256; mode = 1; }
        else if (pn < 11) { base = dk; ld = 1024; c0 = (pn - 7) * 256; mode = 1; }
        else if (pn < 15) { base = dv; ld = 1024; c0 = (pn - 11) * 256; mode = 0; }
        else { base = mq; ld = 512; c0 = (pn - 15) * 256; mode = 0; }
        const int row0 = u.pm * BM + wr * 64 + fr, colw = c0 + wc * 32 + 8 * fq;
#pragma unroll
        for (int ai = 0; ai < 2; ++ai)
#pragma unroll
            for (int m = 0; m < 4; ++m) { const int row = row0 + ai * HALF + m * 16; bf16_t* rowp = base + (size_t)row * ld + colw;
#pragma unroll
                for (int bj = 0; bj < 2; ++bj) { f32x4 v0 = acc[ai][bj][m][0], v1 = acc[ai][bj][m][1];
                    if (mode == 1 && (wc & 1) == 0) {
                        const f32x4 p0 = shx4(v0, 16), p1 = shx4(v1, 16);
                        if (fq < 2) { const f32x4 c0v = *(const f32x4*)(cosd + (size_t)row * 8), c1v = *(const f32x4*)(cosd + (size_t)row * 8 + 4);
                            f32x4 s0v = *(const f32x4*)(sind + (size_t)row * 8), s1v = *(const f32x4*)(sind + (size_t)row * 8 + 4);
                            if (fq == 0) { s0v = -s0v; s1v = -s1v; }
                            v0 = v0 * c0v + p0 * s0v; v1 = v1 * c1v + p1 * s1v; } }
                    if (mode == 2 && bj == 1 && wc == 0) {
                        const f32x4 p0 = shx4(v0, 32), p1 = shx4(v1, 32); const int i16 = (fq & 1) * 8;
                        const f32x4 c0v = *(const f32x4*)(cosm + (size_t)row * 16 + i16), c1v = *(const f32x4*)(cosm + (size_t)row * 16 + i16 + 4);
                        f32x4 s0v = *(const f32x4*)(sinm + (size_t)row * 16 + i16), s1v = *(const f32x4*)(sinm + (size_t)row * 16 + i16 + 4);
                        if (fq < 2) { s0v = -s0v; s1v = -s1v; }
                        v0 = v0 * c0v + p0 * s0v; v1 = v1 * c1v + p1 * s1v; }
                    *(u32x4*)(rowp + bj * HALF) = pack8(v0, v1); }
                asm volatile("" ::: "memory"); }
    }
};
template <bool ROPE> struct EpiScale {
    static constexpr bool PERM = true, AFTER_DRAIN = false;
    bf16_t* O; int ld; const float* rs; const float *cosm, *sinm;
    __device__ __forceinline__ void operator()(const f32x4 (&acc)[2][2][4][2], const Unit& u, int wr, int wc, int fr, int fq) const {
        const int row0 = u.pm * BM + wr * 64 + fr, colw = u.pn * BM + wc * 32 + 8 * fq;
#pragma unroll
        for (int ai = 0; ai < 2; ++ai)
#pragma unroll
            for (int m = 0; m < 4; ++m) { const int row = row0 + ai * HALF + m * 16; bf16_t* rowp = O + (size_t)row * ld + colw;
                const float sc = rs ? __hip_atomic_load(rs + row, __ATOMIC_RELAXED, __HIP_MEMORY_SCOPE_AGENT) : 1.f;
#pragma unroll
                for (int bj = 0; bj < 2; ++bj) { f32x4 v0 = acc[ai][bj][m][0] * sc, v1 = acc[ai][bj][m][1] * sc;
                    if (ROPE && u.pn == 2) {
                        const f32x4 p0 = shx4(v0, 32), p1 = shx4(v1, 32); const int i16 = (fq & 1) * 8;
                        const f32x4 c0v = *(const f32x4*)(cosm + (size_t)row * 16 + i16), c1v = *(const f32x4*)(cosm + (size_t)row * 16 + i16 + 4);
                        f32x4 s0v = *(const f32x4*)(sinm + (size_t)row * 16 + i16), s1v = *(const f32x4*)(sinm + (size_t)row * 16 + i16 + 4);
                        if (fq < 2) { s0v = -s0v; s1v = -s1v; }
                        v0 = v0 * c0v + p0 * s0v; v1 = v1 * c1v + p1 * s1v; }
                    *(u32x4*)(rowp + bj * HALF) = pack8(v0, v1); }
                asm volatile("" ::: "memory"); }
    }
};
struct EpiGate {
    static constexpr bool PERM = true, AFTER_DRAIN = false;
    bf16_t* G; const float* bias;
    __device__ __forceinline__ void operator()(const f32x4 (&acc)[2][2][4][2], const Unit& u, int wr, int wc, int fr, int fq) const {
        const int row0 = u.pm * BM + wr * 64 + fr, colw = u.pn * BM + wc * 32 + 8 * fq;
        f32x4 bv[2][2];
#pragma unroll
        for (int bj = 0; bj < 2; ++bj)
#pragma unroll
            for (int n = 0; n < 2; ++n) bv[bj][n] = *(const f32x4*)(bias + colw + bj * HALF + 4 * n);
#pragma unroll
        for (int ai = 0; ai < 2; ++ai)
#pragma unroll
            for (int m = 0; m < 4; ++m) { bf16_t* rowp = G + (size_t)(row0 + ai * HALF + m * 16) * 1024 + colw;
#pragma unroll
                for (int bj = 0; bj < 2; ++bj) { f32x4 v0 = acc[ai][bj][m][0] + bv[bj][0], v1 = acc[ai][bj][m][1] + bv[bj][1];
                    *(u32x4*)(rowp + bj * HALF) = pack8(v0, v1); }
                asm volatile("" ::: "memory"); }
    }
};
template <bool FIRST> struct EpiBranch {
    static constexpr bool PERM = true, AFTER_DRAIN = false;
    const bf16_t* G; bf16_t* Mg;
    __device__ __forceinline__ void operator()(const f32x4 (&acc)[2][2][4][2], const Unit& u, int wr, int wc, int fr, int fq) const {
        const int row0 = u.pm * BM + wr * 64 + fr, colw = u.pn * BM + wc * 32 + 8 * fq;
#pragma unroll
        for (int ai = 0; ai < 2; ++ai)
#pragma unroll
            for (int m = 0; m < 4; ++m) { const size_t off = (size_t)(row0 + ai * HALF + m * 16) * 1024 + colw;
#pragma unroll
                for (int bj = 0; bj < 2; ++bj) { const u32x4 g = *(const u32x4*)(G + off + bj * HALF);
                    f32x4 v0 = acc[ai][bj][m][0], v1 = acc[ai][bj][m][1];
                    v0[0] *= sgm(bflo(g.x)); v0[1] *= sgm(bfhi(g.x)); v0[2] *= sgm(bflo(g.y)); v0[3] *= sgm(bfhi(g.y)); v1[0] *= sgm(bflo(g.z)); v1[1] *= sgm(bfhi(g.z)); v1[2] *= sgm(bflo(g.w)); v1[3] *= sgm(bfhi(g.w));
                    if (!FIRST) { const u32x4 o = *(const u32x4*)(Mg + off + bj * HALF);
                        v0[0] += bflo(o.x); v0[1] += bfhi(o.x); v0[2] += bflo(o.y); v0[3] += bfhi(o.y); v1[0] += bflo(o.z); v1[1] += bfhi(o.z); v1[2] += bflo(o.w); v1[3] += bfhi(o.w); }
                    *(u32x4*)(Mg + off + bj * HALF) = pack8(v0, v1); }
                asm volatile("" ::: "memory"); }
    }
};
struct EpiRes {
    static constexpr bool PERM = false, AFTER_DRAIN = false;
    float* X; float alpha;
    __device__ __forceinline__ void operator()(const f32x4 (&acc)[2][2][4][2], const Unit& u, int wr, int wc, int fr, int fq) const {
        const int row0 = u.pm * BM + wr * 64 + fr, col0 = u.pn * BM + wc * 32 + 4 * fq;
        float* base = X + (size_t)row0 * 1024 + col0;
        f32x4 xq[2][2][2];
#pragma unroll
        for (int bj = 0; bj < 2; ++bj)
#pragma unroll
            for (int n = 0; n < 2; ++n) xq[0][bj][n] = *(const f32x4*)(base + bj * HALF + n * 16);
#pragma unroll
        for (int it = 0; it < 8; ++it) { const int ai = it >> 2, m = it & 3, cur = it & 1; float* rowp = base + (size_t)(ai * HALF + m * 16) * 1024;
            if (it < 7) { const float* rown = base + (size_t)(((it + 1) >> 2) * HALF + ((it + 1) & 3) * 16) * 1024;
#pragma unroll
                for (int bj = 0; bj < 2; ++bj)
#pragma unroll
                    for (int n = 0; n < 2; ++n) xq[cur ^ 1][bj][n] = *(const f32x4*)(rown + bj * HALF + n * 16); }
#pragma unroll
            for (int bj = 0; bj < 2; ++bj)
#pragma unroll
                for (int n = 0; n < 2; ++n) *(f32x4*)(rowp + bj * HALF + n * 16) = xq[cur][bj][n] * alpha + acc[ai][bj][m][n];
            asm volatile("" ::: "memory"); }
    }
};
struct EpiRelu2 {
    static constexpr bool PERM = true, AFTER_DRAIN = false;
    bf16_t* H; int ld;
    __device__ __forceinline__ void operator()(const f32x4 (&acc)[2][2][4][2], const Unit& u, int wr, int wc, int fr, int fq) const {
        const int row0 = u.pm * BM + wr * 64 + fr, colw = u.pn * BM + wc * 32 + 8 * fq;
#pragma unroll
        for (int ai = 0; ai < 2; ++ai)
#pragma unroll
            for (int m = 0; m < 4; ++m) { bf16_t* rowp = H + (size_t)(row0 + ai * HALF + m * 16) * ld + colw;
#pragma unroll
                for (int bj = 0; bj < 2; ++bj) { f32x4 v0 = acc[ai][bj][m][0], v1 = acc[ai][bj][m][1];
#pragma unroll
                    for (int e = 0; e < 4; ++e) { const float a = fmaxf(v0[e], 0.f), b = fmaxf(v1[e], 0.f); v0[e] = a * a; v1[e] = b * b; }
                    *(u32x4*)(rowp + bj * HALF) = pack8(v0, v1); }
                asm volatile("" ::: "memory"); }
    }
};

template <class Epi, class Sched, bool ALIGN_EPI = false, bool SP2 = false>
__device__ __forceinline__ void gemm_phase(PG8_LAS unsigned char* lds, const Gemm g, const Sched& S, const Epi& E) {
    int tid_ = threadIdx.x; asm volatile("" : "+v"(tid_));
    const int tid = tid_, wid = __builtin_amdgcn_readfirstlane(tid >> 6), lane = tid & 63, wr = wid >> 2, wc = wid & 3, fr = lane & 15, fq = lane >> 4;
    int K_ = g.K; asm volatile("" : "+s"(K_));
    const int K = K_, nt = K / BK;
    unsigned voffA[2], voffB[2];
#pragma unroll
    for (int i = 0; i < 2; ++i) { int R, C; stage_rc(tid * 16 + i * 8192, R, C); const int Rb = Epi::PERM ? ((R & ~31) + perm32(R & 31)) : R;
        voffA[i] = (unsigned)(R * g.lda + C) * 2u; voffB[i] = (unsigned)(Rb * g.ldb + C) * 2u; }
    const size_t kstep = (size_t)(BK * 2);
    const size_t hstepA = (size_t)HALF * g.lda * 2, hstepB = (size_t)HALF * g.ldb * 2;
    const size_t tstepA = 2 * hstepA, tstepB = 2 * hstepB;
    const unsigned ldsw = (unsigned)wid * 1024u;
    const int aoff = lds_byte(wr * 64 + fr, fq * 8), boff = lds_byte(wc * 32 + fr, fq * 8);
#define PG8_SA(b, h) (((b) * 2 + (h)) * HTB)
#define PG8_SB(b, h) ((4 + (b) * 2 + (h)) * HTB)
#define PG8_STAGE(bufoff, gbase, voff) do { _Pragma("unroll") for (int _i = 0; _i < 2; ++_i) \
        __builtin_amdgcn_global_load_lds((const unsigned*)((const char*)(gbase) + (voff)[_i]), (PG8_LAS unsigned*)(lds + (bufoff) + ldsw + _i * 8192), 16, 0, 0); } while (0)
#define PG8_LDA(dst, b, h) do { _Pragma("unroll") for (int m = 0; m < 4; ++m) _Pragma("unroll") for (int k = 0; k < 2; ++k) dst[m][k] = *(const PG8_LAS bf16x8*)(lds + PG8_SA(b, h) + aoff + m * 2048 + k * 1024); } while (0)
#define PG8_LDB(dst, b, h) do { _Pragma("unroll") for (int n = 0; n < 2; ++n) _Pragma("unroll") for (int k = 0; k < 2; ++k) dst[n][k] = *(const PG8_LAS bf16x8*)(lds + PG8_SB(b, h) + boff + n * 2048 + k * 1024); } while (0)
#define PG8_MMA(ai, bj, At, Bt) do { __builtin_amdgcn_s_setprio(1); _Pragma("unroll") for (int m = 0; m < 4; ++m) _Pragma("unroll") for (int n = 0; n < 2; ++n) _Pragma("unroll") for (int k = 0; k < 2; ++k) \
        acc[ai][bj][m][n] = __builtin_amdgcn_mfma_f32_16x16x32_bf16(Bt[n][k], At[m][k], acc[ai][bj][m][n], 0, 0, 0); __builtin_amdgcn_s_setprio(0); } while (0)
#define PG8_WAIT_V(n) asm volatile("s_waitcnt vmcnt(" #n ")" ::: "memory")
#define PG8_WAIT_L(n) asm volatile("s_waitcnt lgkmcnt(" #n ")" ::: "memory")
#define PG8_BAR __builtin_amdgcn_s_barrier()
#define PG8_SCHED __builtin_amdgcn_sched_barrier(0)
    Unit cur, nxt; int ui = 0;
    if (!S.next(0, cur)) return;
    f32x4 acc[2][2][4][2];
#pragma unroll
    for (int a = 0; a < 2; ++a)
#pragma unroll
        for (int b = 0; b < 2; ++b)
#pragma unroll
            for (int m = 0; m < 4; ++m)
#pragma unroll
                for (int n = 0; n < 2; ++n) acc[a][b][m][n] = (f32x4){0.f, 0.f, 0.f, 0.f};
    bf16x8 At[4][2], B0[2][2], B1[2][2];
    const char* cA = (const char*)g.A + (size_t)cur.pm * tstepA; const char* cB = (const char*)g.Bt + (size_t)cur.pn * tstepB;
    S.a_ready(cur);
    if constexpr (SP2) {
        PG8_STAGE(PG8_SB(0, 0), cB, voffB); PG8_STAGE(PG8_SB(0, 1), cB + hstepB, voffB); PG8_STAGE(PG8_SA(0, 0), cA, voffA); PG8_STAGE(PG8_SA(0, 1), cA + hstepA, voffA);
        if (wr == 1) PG8_BAR;
        PG8_WAIT_V(2); PG8_BAR;
        PG8_STAGE(PG8_SB(1, 0), cB + kstep, voffB); PG8_STAGE(PG8_SA(1, 0), cA + kstep, voffA); PG8_STAGE(PG8_SB(1, 1), cB + hstepB + kstep, voffB);
        PG8_WAIT_V(6); PG8_BAR;
    } else {
        PG8_STAGE(PG8_SB(0, 0), cB, voffB); PG8_STAGE(PG8_SA(0, 0), cA, voffA); PG8_STAGE(PG8_SB(0, 1), cB + hstepB, voffB); PG8_STAGE(PG8_SA(0, 1), cA + hstepA, voffA);
        if (wr == 1) PG8_BAR;
        PG8_WAIT_V(4); PG8_BAR;
        PG8_STAGE(PG8_SB(1, 0), cB + kstep, voffB); PG8_STAGE(PG8_SA(1, 0), cA + kstep, voffA); PG8_STAGE(PG8_SB(1, 1), cB + hstepB + kstep, voffB);
        PG8_WAIT_V(6); PG8_BAR;
    }
    for (;;) {
        const bool has_next = S.next(ui + 1, nxt);
        const char* nA = has_next ? (const char*)g.A + (size_t)nxt.pm * tstepA : cA; const char* nB = has_next ? (const char*)g.Bt + (size_t)nxt.pn * tstepB : cB;
        for (int t = 0; t < nt; t += 2) {
            const bool last = (t == nt - 2);
            const char* a1 = cA + (size_t)(t + 1) * kstep;
            const char* a2 = last ? nA : cA + (size_t)(t + 2) * kstep; const char* b2 = last ? nB : cB + (size_t)(t + 2) * kstep;
            const char* a3 = a2 + kstep; const char* b3 = b2 + kstep;
            if (last && has_next) S.a_ready(nxt);
            if constexpr (SP2) {
            PG8_LDB(B0, 0, 0); PG8_LDB(B1, 0, 1); PG8_SCHED; PG8_LDA(At, 0, 0); PG8_STAGE(PG8_SA(1, 1), a1 + hstepA, voffA);
            PG8_WAIT_V(8); PG8_WAIT_L(0); PG8_BAR; PG8_MMA(0, 0, At, B0); PG8_MMA(0, 1, At, B1); PG8_BAR; PG8_SCHED;
            PG8_LDA(At, 0, 1); PG8_STAGE(PG8_SB(0, 0), b2, voffB); PG8_STAGE(PG8_SB(0, 1), b2 + hstepB, voffB); PG8_STAGE(PG8_SA(0, 0), a2, voffA);
            PG8_WAIT_V(8); PG8_WAIT_L(0); PG8_BAR; PG8_MMA(1, 0, At, B0); PG8_MMA(1, 1, At, B1); PG8_BAR; PG8_SCHED;
            PG8_LDB(B0, 1, 0); PG8_LDB(B1, 1, 1); PG8_SCHED; PG8_LDA(At, 1, 0); PG8_STAGE(PG8_SA(0, 1), a2 + hstepA, voffA);
            PG8_WAIT_V(8); PG8_WAIT_L(0); PG8_BAR; PG8_MMA(0, 0, At, B0); PG8_MMA(0, 1, At, B1); PG8_BAR; PG8_SCHED;
            PG8_LDA(At, 1, 1); PG8_STAGE(PG8_SB(1, 0), b3, voffB); PG8_STAGE(PG8_SB(1, 1), b3 + hstepB, voffB); PG8_STAGE(PG8_SA(1, 0), a3, voffA);
            PG8_WAIT_V(8); PG8_WAIT_L(0); PG8_BAR; PG8_MMA(1, 0, At, B0); PG8_MMA(1, 1, At, B1); PG8_BAR; PG8_SCHED;
            } else {
            PG8_LDB(B0, 0, 0); PG8_SCHED; PG8_LDA(At, 0, 0); PG8_STAGE(PG8_SA(1, 1), a1 + hstepA, voffA);
            PG8_WAIT_L(8); PG8_BAR; PG8_WAIT_L(0); PG8_MMA(0, 0, At, B0); PG8_BAR; PG8_SCHED;
            PG8_LDB(B1, 0, 1); PG8_STAGE(PG8_SB(0, 0), b2, voffB);
            PG8_BAR; PG8_WAIT_L(0); PG8_MMA(0, 1, At, B1); PG8_BAR;
            PG8_LDA(At, 0, 1); PG8_STAGE(PG8_SA(0, 0), a2, voffA);
            PG8_BAR; PG8_WAIT_L(0); PG8_MMA(1, 0, At, B0); PG8_BAR; PG8_SCHED;
            PG8_STAGE(PG8_SB(0, 1), b2 + hstepB, voffB);
            PG8_WAIT_V(6); PG8_BAR; PG8_MMA(1, 1, At, B1); PG8_BAR;
            PG8_LDB(B0, 1, 0); PG8_SCHED; PG8_LDA(At, 1, 0); PG8_STAGE(PG8_SA(0, 1), a2 + hstepA, voffA);
            PG8_WAIT_L(8); PG8_BAR; PG8_WAIT_L(0); PG8_MMA(0, 0, At, B0); PG8_BAR; PG8_SCHED;
            PG8_LDB(B1, 1, 1); PG8_STAGE(PG8_SB(1, 0), b3, voffB);
            PG8_BAR; PG8_WAIT_L(0); PG8_MMA(0, 1, At, B1); PG8_BAR;
            PG8_LDA(At, 1, 1); PG8_STAGE(PG8_SA(1, 0), a3, voffA);
            PG8_BAR; PG8_WAIT_L(0); PG8_MMA(1, 0, At, B0); PG8_BAR; PG8_SCHED;
            PG8_STAGE(PG8_SB(1, 1), b3 + hstepB, voffB);
            PG8_WAIT_V(6); PG8_BAR; PG8_MMA(1, 1, At, B1); PG8_BAR;
            }
        }
        if constexpr (ALIGN_EPI) { if (wr == 0) PG8_BAR; }
        if constexpr (!Epi::AFTER_DRAIN) { E(acc, cur, wr, wc, fr, fq); S.done(cur); }
        if (!has_next) break;
#pragma unroll
        for (int a = 0; a < 2; ++a)
#pragma unroll
            for (int b = 0; b < 2; ++b)
#pragma unroll
                for (int m = 0; m < 4; ++m)
#pragma unroll
                    for (int n = 0; n < 2; ++n) acc[a][b][m][n] = (f32x4){0.f, 0.f, 0.f, 0.f};
        cur = nxt; cA = nA; cB = nB; ++ui;
        if constexpr (ALIGN_EPI) { if (wr == 1) PG8_BAR; }
    }
    PG8_WAIT_V(0);
    if constexpr (!ALIGN_EPI) { if (wr == 0) PG8_BAR; }
    PG8_BAR;
    if constexpr (Epi::AFTER_DRAIN) { E.fused(acc, cur, wr, wc, fr, fq, lds, wid, lane); S.done(cur); }
#undef PG8_SA
#undef PG8_SB
#undef PG8_STAGE
#undef PG8_LDA
#undef PG8_LDB
#undef PG8_MMA
#undef PG8_WAIT_V
#undef PG8_WAIT_L
#undef PG8_BAR
#undef PG8_SCHED
}
}

namespace att {
#define LAS __attribute__((address_space(3)))
typedef unsigned short bf16_t;
typedef LAS char* lptr;
using bf16x8 = __attribute__((ext_vector_type(8))) short;
using s16x4  = __attribute__((ext_vector_type(4))) short;
using f32x16 = __attribute__((ext_vector_type(16))) float;
using u32x4  = __attribute__((ext_vector_type(4))) unsigned;
constexpr int V_OFF = 0, K_OFF = 32768, WS_OFF = 67584, STASH_OFF = 69632, ATT_LDS_END = STASH_OFF + 65536;
#define SBAR() __builtin_amdgcn_sched_barrier(0)
__device__ __forceinline__ int crow(int r, int hi) { return (r & 3) + 8 * (r >> 2) + 4 * hi; }
__device__ __forceinline__ unsigned cvtpk(float lo, float hi) { unsigned r; asm volatile("v_cvt_pk_bf16_f32 %0, %1, %2" : "=v"(r) : "v"(lo), "v"(hi)); return r; }
__device__ __forceinline__ unsigned short f2bf(float f) { unsigned u = __builtin_bit_cast(unsigned, f); return (unsigned short)((u + 0x7fffu + ((u >> 16) & 1u)) >> 16); }

struct Args { const bf16_t *Q0, *Q1, *K0, *K1, *V; int ldq, ldk0, ldk1, ldv, nkeys; float C, thr; };

__device__ __forceinline__ void partialSM(f32x16& p0, f32x16& p1, float& m_reg, float& mn, float& alpha, float C, float thr) {
  float pmax = p0[0];
#pragma unroll
  for (int r = 1; r < 16; ++r) pmax = fmaxf(pmax, p0[r]);
#pragma unroll
  for (int r = 0; r < 16; ++r) pmax = fmaxf(pmax, p1[r]);
  { auto rr = __builtin_amdgcn_permlane32_swap(__float_as_uint(pmax), __float_as_uint(pmax), false, false);
    pmax = fmaxf(__uint_as_float(rr[0]), __uint_as_float(rr[1])); }
  if (__builtin_expect(__all(pmax - m_reg <= thr), 1)) { mn = m_reg; alpha = 1.f; }
  else { mn = fmaxf(m_reg, pmax); alpha = __builtin_amdgcn_exp2f((m_reg - mn) * C); m_reg = mn; }
  const float mnC = -mn * C;
#pragma unroll
  for (int r = 0; r < 16; ++r) p0[r] = fmaf(p0[r], C, mnC);
#pragma unroll
  for (int r = 0; r < 16; ++r) p1[r] = fmaf(p1[r], C, mnC);
#pragma unroll
  for (int r = 0; r < 16; ++r) p0[r] = __builtin_amdgcn_exp2f(p0[r]);
}
__device__ __forceinline__ void finishSM(f32x16& p0, f32x16& p1, float alpha, float& l_reg, bf16x8& pa0, bf16x8& pa1, bf16x8& pa2, bf16x8& pa3) {
#pragma unroll
  for (int r = 0; r < 16; ++r) p1[r] = __builtin_amdgcn_exp2f(p1[r]);
  float ps = 0;
#pragma unroll
  for (int r = 0; r < 16; ++r) ps += p0[r];
#pragma unroll
  for (int r = 0; r < 16; ++r) ps += p1[r];
  { auto rr = __builtin_amdgcn_permlane32_swap(__float_as_uint(ps), __float_as_uint(ps), false, false);
    ps = __uint_as_float(rr[0]) + __uint_as_float(rr[1]); }
  l_reg = l_reg * alpha + ps;
#define PK4(P, BASE, OUT) do { unsigned a0 = cvtpk(P[BASE + 0], P[BASE + 1]), a1 = cvtpk(P[BASE + 2], P[BASE + 3]);   \
    unsigned b0 = cvtpk(P[BASE + 4], P[BASE + 5]), b1 = cvtpk(P[BASE + 6], P[BASE + 7]);                              \
    auto r0 = __builtin_amdgcn_permlane32_swap(a0, b0, false, false); auto r1 = __builtin_amdgcn_permlane32_swap(a1, b1, false, false); \
    u32x4 w = {r0[0], r1[0], r0[1], r1[1]}; OUT = __builtin_bit_cast(bf16x8, w); } while (0)
  PK4(p0, 0, pa0); PK4(p0, 8, pa1); PK4(p1, 0, pa2); PK4(p1, 8, pa3);
#undef PK4
}
template <int NQ, int KROW> __device__ __forceinline__ void qkt(f32x16& p0, f32x16& p1, lptr Ks, const bf16x8* qr, int r32, int hi) {
  p0 = f32x16{}; p1 = f32x16{};
#pragma unroll
  for (int d0 = 0; d0 < NQ; ++d0) { const int cb = (d0 * 16 + hi * 8) * 2;
    const bf16x8 b0 = *(const LAS bf16x8*)(Ks + r32 * KROW + cb);
    const bf16x8 b1 = *(const LAS bf16x8*)(Ks + (32 + r32) * KROW + cb);
    p0 = __builtin_amdgcn_mfma_f32_32x32x16_bf16(b0, qr[d0], p0, 0, 0, 0);
    p1 = __builtin_amdgcn_mfma_f32_32x32x16_bf16(b1, qr[d0], p1, 0, 0, 0); }
}
template <int ND> __device__ __forceinline__ int v_st(int k, int c) { const int kk = (k & ~0xC) | ((k & 4) << 1) | ((k & 8) >> 1); return ((kk >> 3) * ND + (c >> 5)) * 512 + ((kk & 7) * 32 + (c & 31)) * 2; }
__device__ __forceinline__ int v_rd_base(int lane) { return ((lane & 3) << 3) | (((lane >> 2) & 3) << 6) | (((lane >> 4) & 1) << 5) | (((lane >> 5) & 1) << 8); }
template <int OFF> __device__ __forceinline__ s16x4 tr_read(int vb) {
  s16x4 r; asm volatile("ds_read_b64_tr_b16 %0, %1 offset:%2" : "=&v"(r) : "v"(vb), "i"(OFF) : "memory"); return r;
}
template <int ND, int D0> __device__ __forceinline__ void pv_one(f32x16& od, int vb, bf16x8 pa0, bf16x8 pa1, bf16x8 pa2, bf16x8 pa3) {
  constexpr int KG = ND * 512;
  const s16x4 l0 = tr_read<D0 * 512 + 0 * KG>(vb), h0 = tr_read<D0 * 512 + 1 * KG>(vb), l1 = tr_read<D0 * 512 + 2 * KG>(vb), h1 = tr_read<D0 * 512 + 3 * KG>(vb);
  const s16x4 l2 = tr_read<D0 * 512 + 4 * KG>(vb), h2 = tr_read<D0 * 512 + 5 * KG>(vb), l3 = tr_read<D0 * 512 + 6 * KG>(vb), h3 = tr_read<D0 * 512 + 7 * KG>(vb);
  asm volatile("s_waitcnt lgkmcnt(0)" ::: "memory"); SBAR();
#define PK(L, H) (bf16x8){L[0], L[1], L[2], L[3], H[0], H[1], H[2], H[3]}
  od = __builtin_amdgcn_mfma_f32_32x32x16_bf16(pa0, PK(l0, h0), od, 0, 0, 0);
  od = __builtin_amdgcn_mfma_f32_32x32x16_bf16(pa1, PK(l1, h1), od, 0, 0, 0);
  od = __builtin_amdgcn_mfma_f32_32x32x16_bf16(pa2, PK(l2, h2), od, 0, 0, 0);
  od = __builtin_amdgcn_mfma_f32_32x32x16_bf16(pa3, PK(l3, h3), od, 0, 0, 0);
#undef PK
}
template <int ND> __device__ __forceinline__ void pv_all(f32x16* o, int vb, bf16x8 pa0, bf16x8 pa1, bf16x8 pa2, bf16x8 pa3) {
  pv_one<ND, 0>(o[0], vb, pa0, pa1, pa2, pa3); pv_one<ND, 1>(o[1], vb, pa0, pa1, pa2, pa3);
  if constexpr (ND == 4) { pv_one<ND, 2>(o[2], vb, pa0, pa1, pa2, pa3); pv_one<ND, 3>(o[3], vb, pa0, pa1, pa2, pa3); }
}

template <int MODE> struct Cfg;
template <> struct Cfg<0> { static constexpr int DQK = 96, DV = 64; };
template <> struct Cfg<1> { static constexpr int DQK = 64, DV = 128; };
template <> struct Cfg<2> { static constexpr int DQK = 128, DV = 128; };

struct Slot { bf16x8 a, b, c, d; };

template <int MODE>
__device__ __forceinline__ void attn_core(const Args& A, lptr lds, f32x16* o, float* rli) {
  constexpr int DQK = Cfg<MODE>::DQK, DV = Cfg<MODE>::DV, NQ = DQK / 16, ND = DV / 32, KROW = DQK * 2 + 16, SHM_K = 64 * KROW, SHM_V = 64 * DV * 2;
  int tid_ = threadIdx.x; asm volatile("" : "+v"(tid_));
  const int tid = tid_, wid = tid >> 6, lane = tid & 63, r32 = lane & 31, hi = lane >> 5;
  const lptr V_lds = lds + V_OFF, K_lds = lds + K_OFF;
  LAS float* ws = (LAS float*)(lds + WS_OFF) + wid * 64; LAS float* li_l = ws; LAS float* al_l = ws + 32;
  float m_reg = -1e30f, l_reg = 0.f;
#pragma unroll
  for (int d = 0; d < ND; ++d) o[d] = f32x16{};
  bf16x8 qr[NQ];
  { const bf16_t* Qw = A.Q0 + (size_t)(wid * 32 + r32) * A.ldq + hi * 8;
    if constexpr (MODE == 0) {
#pragma unroll
      for (int d0 = 0; d0 < 4; ++d0) qr[d0] = *(const bf16x8*)(Qw + d0 * 16);
      const bf16_t* Qw1 = A.Q1 + (size_t)(wid * 32 + r32) * A.ldq + hi * 8;
      qr[4] = *(const bf16x8*)(Qw1); qr[5] = *(const bf16x8*)(Qw1 + 16);
    } else {
#pragma unroll
      for (int d0 = 0; d0 < NQ; ++d0) qr[d0] = *(const bf16x8*)(Qw + d0 * 16);
    } }
  const int vb0 = (int)(uintptr_t)V_lds + v_rd_base(lane);
  Slot sr_[2];
  const int r8 = tid >> 3, c8 = (tid & 7) * 8;
  const int r16 = tid >> 4, c16 = (tid & 15) * 8;
  const int rr4 = (tid & 255) >> 2, cr4 = (tid & 3) * 8;
#define SLOAD(i, k0) do { \
    if constexpr (MODE == 0) { sr_[i].a = *(const bf16x8*)(A.K0 + (size_t)((k0) + r8) * A.ldk0 + c8); sr_[i].b = *(const bf16x8*)(A.K1 + (size_t)((k0) + rr4) * A.ldk1 + cr4); \
                               sr_[i].c = *(const bf16x8*)(A.V + (size_t)((k0) + r8) * A.ldv + c8); } \
    else if constexpr (MODE == 1) { sr_[i].a = *(const bf16x8*)(A.K0 + (size_t)((k0) + r8) * A.ldk0 + c8); \
                               sr_[i].c = *(const bf16x8*)(A.V + (size_t)((k0) + r16) * A.ldv + c16); sr_[i].d = *(const bf16x8*)(A.V + (size_t)((k0) + 32 + r16) * A.ldv + c16); } \
    else { sr_[i].a = *(const bf16x8*)(A.K0 + (size_t)((k0) + r16) * A.ldk0 + c16); sr_[i].b = *(const bf16x8*)(A.K0 + (size_t)((k0) + 32 + r16) * A.ldk0 + c16); \
           sr_[i].c = *(const bf16x8*)(A.V + (size_t)((k0) + r16) * A.ldv + c16); sr_[i].d = *(const bf16x8*)(A.V + (size_t)((k0) + 32 + r16) * A.ldv + c16); } } while (0)
#define SWRITE(bf, i) do { const lptr Kb = K_lds + (bf) * SHM_K; const lptr Vb = V_lds + (bf) * SHM_V; \
    if constexpr (MODE == 0) { *(LAS bf16x8*)(Kb + r8 * KROW + c8 * 2) = sr_[i].a; if (tid < 256) *(LAS bf16x8*)(Kb + rr4 * KROW + 128 + cr4 * 2) = sr_[i].b; \
                               *(LAS bf16x8*)(Vb + v_st<ND>(r8, c8)) = sr_[i].c; } \
    else if constexpr (MODE == 1) { *(LAS bf16x8*)(Kb + r8 * KROW + c8 * 2) = sr_[i].a; \
                               *(LAS bf16x8*)(Vb + v_st<ND>(r16, c16)) = sr_[i].c; *(LAS bf16x8*)(Vb + v_st<ND>(32 + r16, c16)) = sr_[i].d; } \
    else { *(LAS bf16x8*)(Kb + r16 * KROW + c16 * 2) = sr_[i].a; *(LAS bf16x8*)(Kb + (32 + r16) * KROW + c16 * 2) = sr_[i].b; \
           *(LAS bf16x8*)(Vb + v_st<ND>(r16, c16)) = sr_[i].c; *(LAS bf16x8*)(Vb + v_st<ND>(32 + r16, c16)) = sr_[i].d; } } while (0)
#define SWAIT() do { if constexpr (MODE == 2) asm volatile("s_waitcnt vmcnt(4)" ::: "memory"); else asm volatile("s_waitcnt vmcnt(3)" ::: "memory"); } while (0)
#define ATT_BAR() asm volatile("s_waitcnt lgkmcnt(0)\n\ts_barrier" ::: "memory")
#define RESC(a) do { if (__any((a) < 1.f)) { if (hi == 0) al_l[r32] = (a); asm volatile("s_waitcnt lgkmcnt(0)" ::: "memory"); \
    _Pragma("unroll") for (int d = 0; d < ND; ++d) _Pragma("unroll") for (int r = 0; r < 16; ++r) o[d][r] *= al_l[crow(r, hi)]; } } while (0)
  f32x16 pA0, pA1, pB0, pB1; float mnA, mnB, alA, alB; bf16x8 pa0, pa1, pa2, pa3; const int NT = A.nkeys / 64;
  const float C = A.C, thr = A.thr;
  SLOAD(0, 0); asm volatile("s_waitcnt vmcnt(0)" ::: "memory"); SWRITE(0, 0); ATT_BAR();
  qkt<NQ, KROW>(pA0, pA1, K_lds, qr, r32, hi); partialSM(pA0, pA1, m_reg, mnA, alA, C, thr);
  SLOAD(1, 64); if (2 < NT) SLOAD(0, 128);
  SWAIT(); SWRITE(1, 1); ATT_BAR();
  for (int j = 1; j + 1 < NT; j += 2) {
    SBAR(); qkt<NQ, KROW>(pB0, pB1, K_lds + SHM_K, qr, r32, hi);
    finishSM(pA0, pA1, alA, l_reg, pa0, pa1, pa2, pa3); SBAR();
    SLOAD(1, (j + 2) * 64); SBAR();
    pv_all<ND>(o, vb0, pa0, pa1, pa2, pa3); partialSM(pB0, pB1, m_reg, mnB, alB, C, thr);
    ATT_BAR(); SWAIT(); SWRITE(0, 0);
    RESC(alB); ATT_BAR();
    SBAR(); qkt<NQ, KROW>(pA0, pA1, K_lds, qr, r32, hi);
    finishSM(pB0, pB1, alB, l_reg, pa0, pa1, pa2, pa3); SBAR();
    if (j + 3 < NT) SLOAD(0, (j + 3) * 64); SBAR();
    pv_all<ND>(o, vb0 + SHM_V, pa0, pa1, pa2, pa3); partialSM(pA0, pA1, m_reg, mnA, alA, C, thr);
    ATT_BAR(); SWAIT(); SWRITE(1, 1);
    RESC(alA); ATT_BAR();
  }
  SBAR(); qkt<NQ, KROW>(pB0, pB1, K_lds + SHM_K, qr, r32, hi);
  finishSM(pA0, pA1, alA, l_reg, pa0, pa1, pa2, pa3); SBAR();
  pv_all<ND>(o, vb0, pa0, pa1, pa2, pa3); partialSM(pB0, pB1, m_reg, mnB, alB, C, thr);
  ATT_BAR(); RESC(alB);
  finishSM(pB0, pB1, alB, l_reg, pa0, pa1, pa2, pa3); SBAR();
  pv_all<ND>(o, vb0 + SHM_V, pa0, pa1, pa2, pa3);
  if (hi == 0) li_l[r32] = l_reg; asm volatile("s_waitcnt lgkmcnt(0)" ::: "memory");
#pragma unroll
  for (int r = 0; r < 16; ++r) rli[r] = __builtin_amdgcn_rcpf(li_l[crow(r, hi)]);
  ATT_BAR();
#undef SLOAD
#undef SWRITE
#undef SWAIT
#undef RESC
#undef ATT_BAR
}
}

typedef unsigned short bf16;
typedef float f32x4 __attribute__((ext_vector_type(4)));
typedef unsigned v4u __attribute__((ext_vector_type(4)));
constexpr int T = 32768, DM = 1024, SEQ = 2048, NBATCH = 16, DEPTH = 4, MEMLEN = 256, NIN = 7328, DFF = 4096;
constexpr int NWAVES = 8, NTHREADS = 512;
constexpr float ALPHA = 1.6817928305074290f;
constexpr int LDS_BYTES = 139264;
static_assert(att::ATT_LDS_END <= LDS_BYTES && pg8::STAGE_BYTES <= LDS_BYTES, "LDS map");
constexpr size_t MiB = 1u << 20;
constexpr size_t WS_BAR = 512 * 1024;
constexpr size_t WS_RSQ = 0, WS_RSKV = 256 * 1024;
constexpr size_t WS_COSM = 1 * MiB, WS_SINM = 3 * MiB, WS_COSD = 5 * MiB, WS_SIND = 6 * MiB;
constexpr size_t WS_W = 8 * MiB;
constexpr size_t WS_MEMB = 48 * MiB, WS_MEMKV = 56 * MiB, WS_XB = 64 * MiB;
constexpr size_t WS_DQ = 128 * MiB, WS_MQ = 192 * MiB, WS_QM = 224 * MiB, WS_LAT = 272 * MiB, WS_DK = 320 * MiB, WS_DV = 384 * MiB, WS_KVM = 448 * MiB, WS_END = 512 * MiB;
constexpr size_t WS_G = 272 * MiB, WS_MG = 336 * MiB;
constexpr size_t WS_HID = 128 * MiB;
constexpr size_t WO_IN = 0, WO_G = WO_IN + (size_t)4352 * 1024, WO_UQ = WO_G + (size_t)3072 * 1024, WO_UKV = WO_UQ + (size_t)768 * 384, WO_MKV = WO_UKV + (size_t)1024 * 256,
                 WO_BM = WO_MKV + (size_t)1024 * 1024, WO_BD = WO_BM + (size_t)1024 * 512, WO_BE = WO_BD + (size_t)1024 * 1024, WO_OUT = WO_BE + (size_t)1024 * 512,
                 WO_1 = WO_OUT + (size_t)1024 * 1024, WO_2 = WO_1 + (size_t)4096 * 1024, WO_END = WO_2 + (size_t)4096 * 1024;
static_assert(WO_END * 2 <= 40 * MiB, "weight copies fit");

struct Params {
    const float *x, *mem; const int* pos;
    const float *w_in, *b_gate, *q_norm, *kv_norm, *w_uq, *w_ukv, *dlam, *subln, *w_mkv, *w_br, *w_out, *ln1g, *ln1b, *w1, *w2, *ln2g, *ln2b;
    float* out; unsigned char* ws;
};
typedef const __attribute__((address_space(4))) Params* kparams_t;
__device__ __forceinline__ kparams_t getp() { kparams_t kp = (kparams_t)__builtin_amdgcn_kernarg_segment_ptr(); asm volatile("" : "+s"(kp)); return kp; }

#define LDS_WAIT() asm volatile("s_waitcnt lgkmcnt(0)" ::: "memory")
__device__ __forceinline__ unsigned f2bf_u(float f) { unsigned u = __builtin_bit_cast(unsigned, f); return (u + 0x7fffu + ((u >> 16) & 1u)) >> 16; }
__device__ __forceinline__ unsigned pk2(float lo, float hi) { return f2bf_u(lo) | (f2bf_u(hi) << 16); }
__device__ __forceinline__ float wave_sum(float v) {
#pragma unroll
    for (int o = 1; o < 64; o <<= 1) v += __shfl_xor(v, o);
    return v;
}

__device__ __forceinline__ void tr_item(const float* W, int ldw, int sc, int K, bf16* WT, int n0, int k0, const float* gain, LAS float* scr, int lane) {
    float vv[32];
#pragma unroll
    for (int i = 0; i < 32; ++i) { const int kk = 2 * i + (lane >> 5); vv[i] = (sc >= 0) ? W[(size_t)(k0 + kk) * ldw + sc + (lane & 31)] : 0.f; }
#pragma unroll
    for (int i = 0; i < 32; ++i) { const int kk = 2 * i + (lane >> 5); float v = vv[i]; if (sc >= 0 && gain) v *= gain[k0 + kk]; scr[kk * 33 + (lane & 31)] = v; }
    LDS_WAIT(); asm volatile("" ::: "memory");
    const int c = lane & 7;
#pragma unroll
    for (int j = 0; j < 4; ++j) { const int n = (lane >> 3) + 8 * j; const LAS float* s = scr + (8 * c) * 33 + n;
        v4u o; o.x = pk2(s[0 * 33], s[1 * 33]); o.y = pk2(s[2 * 33], s[3 * 33]); o.z = pk2(s[4 * 33], s[5 * 33]); o.w = pk2(s[6 * 33], s[7 * 33]);
        *(v4u*)(WT + (size_t)(n0 + n) * K + k0 + 8 * c) = o; }
    LDS_WAIT(); asm volatile("" ::: "memory");
}
__device__ __forceinline__ bool tr_job(int& it, const float* W, int ldw, int K, int N, bf16* WT, int kind, int coff, const float* gain, LAS float* scr, int lane) {
    const int nblk = N / 32, items = (K / 64) * nblk;
    if (it >= items) { it -= items; return false; }
    const int kb = it / nblk, nb = it % nblk, n0 = 32 * nb; int sc;
    if (kind == 0) sc = n0 + coff;
    else if (kind == 1) sc = (n0 < 672) ? n0 : (n0 < 768 ? -1 : n0 - 96);
    else sc = (n0 < 512) ? (n0 >> 6) * 96 + (n0 & 63) : ((n0 - 512) >> 5) * 96 + 64;
    tr_item(W, ldw, sc, K, WT, n0, 64 * kb, gain, scr, lane);
    return true;
}
__device__ __forceinline__ void convert_weights(int l, LAS unsigned char* lds, int gw, int NGW, int wave, int lane_) {
    int lane = lane_; asm volatile("" : "+v"(lane)); const kparams_t kp = getp();
    LAS float* scr = (LAS float*)(lds + wave * 16384);
    bf16* Wb = (bf16*)(kp->ws + WS_W);
    const float* w_in = kp->w_in + (size_t)l * DM * NIN; const float* wbr = kp->w_br + (size_t)l * 2048 * 1024;
    constexpr int NITEMS = 16 * 136 + 16 * 96 + 6 * 24 + 4 * 32 + 16 * 32 + 8 * 32 + 16 * 32 + 8 * 32 + 16 * 32 + 16 * 128 + 64 * 32;
    for (int item = gw; item < NITEMS; item += NGW) {
        int it = item;
        if (tr_job(it, w_in, NIN, 1024, 4352, Wb + WO_IN, 1, 0, nullptr, scr, lane)) continue;
        if (tr_job(it, w_in, NIN, 1024, 3072, Wb + WO_G, 0, 4256, nullptr, scr, lane)) continue;
        if (tr_job(it, kp->w_uq + (size_t)l * 384 * 768, 768, 384, 768, Wb + WO_UQ, 2, 0, kp->q_norm + l * 384, scr, lane)) continue;
        if (tr_job(it, kp->w_ukv + (size_t)l * 256 * 1024, 1024, 256, 1024, Wb + WO_UKV, 0, 0, kp->kv_norm + l * 256, scr, lane)) continue;
        if (tr_job(it, kp->w_mkv + (size_t)l * 1024 * 1024, 1024, 1024, 1024, Wb + WO_MKV, 0, 0, nullptr, scr, lane)) continue;
        if (tr_job(it, wbr, 1024, 512, 1024, Wb + WO_BM, 0, 0, nullptr, scr, lane)) continue;
        if (tr_job(it, wbr + (size_t)512 * 1024, 1024, 1024, 1024, Wb + WO_BD, 0, 0, nullptr, scr, lane)) continue;
        if (tr_job(it, wbr + (size_t)1536 * 1024, 1024, 512, 1024, Wb + WO_BE, 0, 0, nullptr, scr, lane)) continue;
        if (tr_job(it, kp->w_out + (size_t)l * 1024 * 1024, 1024, 1024, 1024, Wb + WO_OUT, 0, 0, nullptr, scr, lane)) continue;
        if (tr_job(it, kp->w1 + (size_t)l * 1024 * 4096, 4096, 1024, 4096, Wb + WO_1, 0, 0, nullptr, scr, lane)) continue;
        tr_job(it, kp->w2 + (size_t)l * 4096 * 1024, 1024, 4096, 1024, Wb + WO_2, 0, 0, nullptr, scr, lane);
    }
}
__device__ __forceinline__ void ln_rows(float* X, bf16* XB, const float* g, const float* b, int gw, int NGW, int lane_, int row_end = T) {
    int lane = lane_; asm volatile("" : "+v"(lane));
    f32x4 gv[4], bv[4];
#pragma unroll
    for (int j = 0; j < 4; ++j) { gv[j] = ((const f32x4*)g)[lane + 64 * j]; bv[j] = ((const f32x4*)b)[lane + 64 * j]; }
    for (int m = gw; m < row_end; m += 2 * NGW) {
        const int m2 = (m + NGW < row_end) ? m + NGW : m;
        f32x4* xr = (f32x4*)(X + (size_t)m * DM) + lane; f32x4* xr2 = (f32x4*)(X + (size_t)m2 * DM) + lane; f32x4 v[4], w[4]; float s = 0.f, t = 0.f;
#pragma unroll
        for (int j = 0; j < 4; ++j) { v[j] = xr[64 * j]; w[j] = xr2[64 * j]; }
#pragma unroll
        for (int j = 0; j < 4; ++j) { s += (v[j].x + v[j].y) + (v[j].z + v[j].w); t += (w[j].x + w[j].y) + (w[j].z + w[j].w); }
        const float mean = wave_sum(s) * (1.f / DM), mean2 = wave_sum(t) * (1.f / DM); float s2 = 0.f, t2 = 0.f;
#pragma unroll
        for (int j = 0; j < 4; ++j) { v[j] = v[j] - mean; s2 += (v[j].x * v[j].x + v[j].y * v[j].y) + (v[j].z * v[j].z + v[j].w * v[j].w);
                                      w[j] = w[j] - mean2; t2 += (w[j].x * w[j].x + w[j].y * w[j].y) + (w[j].z * w[j].z + w[j].w * w[j].w); }
        const float rstd = 1.f / sqrtf(wave_sum(s2) * (1.f / DM) + 1e-5f), rstd2 = 1.f / sqrtf(wave_sum(t2) * (1.f / DM) + 1e-5f);
        unsigned long long* o8 = (unsigned long long*)(XB + (size_t)m * DM) + lane; unsigned long long* o82 = (unsigned long long*)(XB + (size_t)m2 * DM) + lane;
#pragma unroll
        for (int j = 0; j < 4; ++j) { const f32x4 y = v[j] * rstd * gv[j] + bv[j]; xr[64 * j] = y;
            o8[64 * j] = (unsigned long long)pk2(y.x, y.y) | ((unsigned long long)pk2(y.z, y.w) << 32); }
        if (m2 != m) {
#pragma unroll
        for (int j = 0; j < 4; ++j) { const f32x4 y = w[j] * rstd2 * gv[j] + bv[j]; xr2[64 * j] = y;
            o82[64 * j] = (unsigned long long)pk2(y.x, y.y) | ((unsigned long long)pk2(y.z, y.w) << 32); } }
    }
}
__device__ __forceinline__ void rowscale_rows(const bf16* lat, float* rsq, float* rskv, int gw, int NGW, int lane_) {
    int lane = lane_; asm volatile("" : "+v"(lane));
    for (int row = gw; row < T; row += 4 * NGW) {
        unsigned w[4][5];
#pragma unroll
        for (int q = 0; q < 4; ++q) { const int rq = (row + q * NGW < T) ? row + q * NGW : row; const unsigned* src = (const unsigned*)(lat + (size_t)rq * 768) + lane;
#pragma unroll
            for (int k = 0; k < 5; ++k) w[q][k] = src[64 * k]; }
#pragma unroll
        for (int q = 0; q < 4; ++q) { float sq = 0.f, sk = 0.f;
#pragma unroll
            for (int k = 0; k < 5; ++k) { const float a = __uint_as_float(w[q][k] << 16), b = __uint_as_float(w[q][k] & 0xffff0000u); if (k < 3) sq += a * a + b * b; else sk += a * a + b * b; }
            sq = wave_sum(sq); sk = wave_sum(sk);
            if (lane == 0 && row + q * NGW < T) { rsq[row + q * NGW] = 1.0f / sqrtf(sq * (1.f / 384.f) + 1e-6f); rskv[row + q * NGW] = 1.0f / sqrtf(sk * (1.f / 256.f) + 1e-6f); } }
    }
}

#ifndef PH_MASK
#define PH_MASK 0xffff
#endif

#define WSP(T_, off) ((T_*)(ws + (off)))
__device__ __forceinline__ void grid_barrier(unsigned* cnt, unsigned target) {
    asm volatile("s_waitcnt vmcnt(0) lgkmcnt(0)" ::: "memory");
    __syncthreads();
    if (threadIdx.x == 0) {
        __builtin_amdgcn_fence(__ATOMIC_RELEASE, "agent");
        asm volatile("s_waitcnt vmcnt(0)" ::: "memory");
        __hip_atomic_fetch_add(cnt, 1u, __ATOMIC_RELAXED, __HIP_MEMORY_SCOPE_AGENT);
        while (__hip_atomic_load(cnt, __ATOMIC_RELAXED, __HIP_MEMORY_SCOPE_AGENT) < target) __builtin_amdgcn_s_sleep(2);
        __builtin_amdgcn_fence(__ATOMIC_ACQUIRE, "agent");
        asm volatile("s_waitcnt vmcnt(0)" ::: "memory");
    }
    __syncthreads();
}
#define GRID_SYNC() do { nsync += (unsigned)G; grid_barrier(bar_cnt, nsync); } while (0)
__global__ void __launch_bounds__(NTHREADS, 2) fwd_megakernel(Params p_unused) {
    extern __shared__ __attribute__((aligned(16))) unsigned char lds_raw[];
    cg::grid_group grid = cg::this_grid();
    LAS unsigned char* lds = (LAS unsigned char*)lds_raw;
    const int tid = threadIdx.x, lane = tid & 63, wave = __builtin_amdgcn_readfirstlane(tid >> 6);
    const int G = gridDim.x, bx = blockIdx.x;
    const int vcu = (G % 8 == 0) ? (bx % 8) * (G / 8) + bx / 8 : bx;
    const int gw = vcu * NWAVES + wave, NGW = G * NWAVES;
    unsigned nsync = 0u; unsigned* bar_cnt = (unsigned*)(getp()->ws + WS_BAR);
    grid.sync();

#if (PH_MASK & 1)
    {   const kparams_t kp = getp(); unsigned char* ws = kp->ws; float* X = kp->out; const float* xin = kp->x; const float* memin = kp->mem; const int* pos = kp->pos;
        bf16 *XB = WSP(bf16, WS_XB), *MEMB = WSP(bf16, WS_MEMB);
        float *COSM = WSP(float, WS_COSM), *SINM = WSP(float, WS_SINM), *COSD = WSP(float, WS_COSD), *SIND = WSP(float, WS_SIND);
        const long gt = (long)bx * NTHREADS + tid, NGT = (long)G * NTHREADS;
        for (long i = gt; i < (long)T * DM / 4; i += 4 * NGT) { f32x4 v[4];
#pragma unroll
            for (int q = 0; q < 4; ++q) v[q] = (i + q * NGT < (long)T * DM / 4) ? ((const f32x4*)xin)[i + q * NGT] : (f32x4){0.f, 0.f, 0.f, 0.f};
#pragma unroll
            for (int q = 0; q < 4; ++q) if (i + q * NGT < (long)T * DM / 4) { ((f32x4*)X)[i + q * NGT] = v[q];
                ((unsigned long long*)XB)[i + q * NGT] = (unsigned long long)pk2(v[q].x, v[q].y) | ((unsigned long long)pk2(v[q].z, v[q].w) << 32); } }
        for (long i = gt; i < (long)NBATCH * MEMLEN * DM / 4; i += NGT) { const f32x4 v = ((const f32x4*)memin)[i];
            ((unsigned long long*)MEMB)[i] = (unsigned long long)pk2(v.x, v.y) | ((unsigned long long)pk2(v.z, v.w) << 32); }
        for (long i = gt; i < (long)T * 16; i += NGT) { const int t = (int)(i >> 4), j = (int)(i & 15); const float inv = exp2f(-(float)(2 * j) * (18.931568569324174f / 32.f)); const float ang = (float)pos[t] * inv;
            const double a = (double)ang, n = rint(a * 0.15915494309189535), r = a - n * 6.283185307179586;
            COSM[i] = (float)cos(r); SINM[i] = (float)sin(r); }
        for (long i = gt; i < (long)T * 8; i += NGT) { const int t = (int)(i >> 3), j = (int)(i & 7); const float inv = exp2f(-(float)(2 * j) * (18.931568569324174f / 16.f)); const float ang = (float)pos[t] * inv;
            const double a = (double)ang, n = rint(a * 0.15915494309189535), r = a - n * 6.283185307179586;
            COSD[i] = (float)cos(r); SIND[i] = (float)sin(r); }
        convert_weights(0, lds, gw, NGW, wave, lane);
    }
    GRID_SYNC();
#endif

    for (int l = 0; l < DEPTH; ++l) {
        const float lambda_init = 0.8f - 0.6f * __expf(-0.3f * (float)l);
#if (PH_MASK & 2)
        {   const kparams_t kp = getp(); unsigned char* ws = kp->ws; bf16* Wb = WSP(bf16, WS_W);
            {   pg8::Gemm g{WSP(bf16, WS_XB), Wb + WO_IN, T, 4352, 1024, 1024, 1024}; pg8::StaticOrder S; S.init(T, 4352, G, bx);
                pg8::EpiH E{WSP(bf16, WS_LAT), WSP(bf16, WS_DQ), WSP(bf16, WS_DK), WSP(bf16, WS_DV), WSP(bf16, WS_MQ), WSP(float, WS_COSD), WSP(float, WS_SIND), WSP(float, WS_COSM), WSP(float, WS_SINM)};
                pg8::gemm_phase<pg8::EpiH, pg8::StaticOrder, true, true>(lds, g, S, E); }
            {   pg8::Gemm g{WSP(bf16, WS_MEMB), Wb + WO_MKV, NBATCH * MEMLEN, 1024, 1024, 1024, 1024}; pg8::StaticOrder S; S.init(NBATCH * MEMLEN, 1024, G, (bx + G / 2) % G);
                pg8::EpiScale<false> E{WSP(bf16, WS_MEMKV), 1024, nullptr, nullptr, nullptr};
                pg8::gemm_phase<pg8::EpiScale<false>, pg8::StaticOrder, true, true>(lds, g, S, E); } }
        GRID_SYNC();
#endif
#if (PH_MASK & 4)
        {   const kparams_t kp = getp(); unsigned char* ws = kp->ws; bf16* Wb = WSP(bf16, WS_W); bf16* LAT = WSP(bf16, WS_LAT); float *RSQ = WSP(float, WS_RSQ), *RSKV = WSP(float, WS_RSKV);
            rowscale_rows(LAT, RSQ, RSKV, gw, NGW, lane);
            GRID_SYNC();
            pg8::StaticOrder Sq; Sq.init(T, 768, G, bx); pg8::StaticOrder Skv; Skv.init(T, 1024, G, bx);
            {   pg8::Gemm g{LAT, Wb + WO_UQ, T, 768, 384, 768, 384}; pg8::EpiScale<true> E{WSP(bf16, WS_QM), 768, RSQ, WSP(float, WS_COSM), WSP(float, WS_SINM)};
                pg8::gemm_phase<pg8::EpiScale<true>, pg8::StaticOrder, true, true>(lds, g, Sq, E); }
            {   pg8::Gemm g{LAT + 384, Wb + WO_UKV, T, 1024, 256, 768, 256}; pg8::EpiScale<false> E{WSP(bf16, WS_KVM), 1024, RSKV, nullptr, nullptr};
                pg8::gemm_phase<pg8::EpiScale<false>, pg8::StaticOrder, true, true>(lds, g, Skv, E); } }
        GRID_SYNC();
#endif
        {
            const att::lptr alds = (att::lptr)lds;
            { const int rep = 1;
            int lane_a = lane; asm volatile("" : "+v"(lane_a)); const int r32 = lane_a & 31, hi = lane_a >> 5;
#if (PH_MASK & 8)
            {   const kparams_t kp = getp(); unsigned char* ws = kp->ws; bf16 *DQ = WSP(bf16, WS_DQ), *DK = WSP(bf16, WS_DK), *DV = WSP(bf16, WS_DV);
                float lam;
                {   const float* dl = kp->dlam + (size_t)l * 256; const float a = wave_sum(dl[lane_a] * dl[64 + lane_a]), b2 = wave_sum(dl[128 + lane_a] * dl[192 + lane_a]);
                    lam = __expf(a) - __expf(b2) + lambda_init; }
                const float* subln = kp->subln + l * 128;
                for (int idx = vcu; idx < NBATCH * 8 * 8; idx += G) {
                    const int bh = idx >> 3, qb = idx & 7, b = bh >> 3, h = bh & 7; const size_t row0 = (size_t)b * SEQ + qb * 256, key0 = (size_t)b * SEQ;
                    att::f32x16 o[4]; float rli[16];
                    att::Args A; A.ldq = 1024; A.ldk0 = 1024; A.ldk1 = 0; A.ldv = 1024; A.nkeys = SEQ; A.C = 0.125f * 1.4426950408889634f; A.thr = 8.f / 0.125f; A.Q1 = nullptr; A.K1 = nullptr;
                    A.Q0 = DQ + row0 * 1024 + h * 128; A.K0 = DK + key0 * 1024 + h * 128; A.V = DV + key0 * 1024 + h * 128;
                    att::attn_core<1>(A, alds, o, rli);
                    int ls = lane_a; asm volatile("" : "+v"(ls)); LAS unsigned* stash = (LAS unsigned*)(lds + att::STASH_OFF) + wave * 2048 + ls;
#pragma unroll
                    for (int d = 0; d < 4; ++d)
#pragma unroll
                        for (int j = 0; j < 8; ++j) stash[(d * 8 + j) * 64] = att::cvtpk(o[d][2 * j] * rli[2 * j], o[d][2 * j + 1] * rli[2 * j + 1]);
                    A.Q0 += 64; A.K0 += 64;
                    att::attn_core<1>(A, alds, o, rli);
                    float ss[16];
#pragma unroll
                    for (int r = 0; r < 16; ++r) ss[r] = 0.f;
#pragma unroll
                    for (int d = 0; d < 4; ++d)
#pragma unroll
                        for (int j = 0; j < 8; ++j) { const unsigned w = stash[(d * 8 + j) * 64];
                            const float d0v = __uint_as_float(w << 16) - lam * (o[d][2 * j] * rli[2 * j]), d1v = __uint_as_float(w & 0xffff0000u) - lam * (o[d][2 * j + 1] * rli[2 * j + 1]);
                            o[d][2 * j] = d0v; o[d][2 * j + 1] = d1v; ss[2 * j] += d0v * d0v; ss[2 * j + 1] += d1v * d1v; }
#pragma unroll
                    for (int r = 0; r < 16; ++r) { float s = ss[r]; s += __shfl_xor(s, 1); s += __shfl_xor(s, 2); s += __shfl_xor(s, 4); s += __shfl_xor(s, 8); s += __shfl_xor(s, 16);
                        ss[r] = (1.0f / sqrtf(s * (1.f / 128.f) + 1e-5f)) * (1.f - lambda_init); }
                    int lq = lane_a; asm volatile("" : "+v"(lq));
                    bf16* Ob = DQ + (row0 + wave * 32 + 4 * (lq >> 5)) * 1024 + h * 128 + (lq & 31);
#pragma unroll
                    for (int d = 0; d < 4; ++d) { const float gsub = subln[d * 32 + (lq & 31)];
#pragma unroll
                        for (int r = 0; r < 16; ++r) if (rep) Ob[att::crow(r, 0) * 1024 + d * 32] = att::f2bf(o[d][r] * ss[r] * gsub); }
                } }
#endif
#if (PH_MASK & 16)
            {   const kparams_t kp = getp(); unsigned char* ws = kp->ws; bf16 *QM = WSP(bf16, WS_QM), *KVM = WSP(bf16, WS_KVM), *LAT = WSP(bf16, WS_LAT);
                for (int idx = vcu; idx < NBATCH * 8 * 8; idx += G) {
                    const int bh = idx >> 3, qb = idx & 7, b = bh >> 3, h = bh & 7; const size_t row0 = (size_t)b * SEQ + qb * 256, key0 = (size_t)b * SEQ;
                    att::f32x16 o[2]; float rli[16];
                    att::Args A; A.ldq = 768; A.ldk0 = 1024; A.ldk1 = 768; A.ldv = 1024; A.nkeys = SEQ; A.C = 0.10206207261596575f * 1.4426950408889634f; A.thr = 8.f / 0.10206207261596575f;
                    A.Q0 = QM + row0 * 768 + h * 64; A.Q1 = QM + row0 * 768 + 512 + h * 32; A.K0 = KVM + key0 * 1024 + h * 128; A.K1 = LAT + key0 * 768 + 640; A.V = KVM + key0 * 1024 + h * 128 + 64;
                    att::attn_core<0>(A, alds, o, rli);
                    int lq = lane_a; asm volatile("" : "+v"(lq));
                    bf16* Ob = QM + (row0 + wave * 32 + 4 * (lq >> 5)) * 768 + h * 64 + (lq & 31);
#pragma unroll
                    for (int d = 0; d < 2; ++d)
#pragma unroll
                        for (int r = 0; r < 16; ++r) if (rep) Ob[att::crow(r, 0) * 768 + d * 32] = att::f2bf(o[d][r] * rli[r]);
                } }
#endif
#if (PH_MASK & 32)
            {   const kparams_t kp = getp(); unsigned char* ws = kp->ws; bf16 *MQ = WSP(bf16, WS_MQ), *MEMKV = WSP(bf16, WS_MEMKV);
                for (int idx = vcu; idx < NBATCH * 4 * 8; idx += G) {
                    const int bh = idx >> 3, qb = idx & 7, b = bh >> 2, h = bh & 3; const size_t row0 = (size_t)b * SEQ + qb * 256, key0 = (size_t)b * MEMLEN;
                    att::f32x16 o[4]; float rli[16];
                    att::Args A; A.ldq = 512; A.ldk0 = 1024; A.ldk1 = 0; A.ldv = 1024; A.nkeys = MEMLEN; A.C = 0.08838834764831845f * 1.4426950408889634f; A.thr = 8.f / 0.08838834764831845f; A.Q1 = nullptr; A.K1 = nullptr;
                    A.Q0 = MQ + row0 * 512 + h * 128; A.K0 = MEMKV + key0 * 1024 + h * 128; A.V = MEMKV + key0 * 1024 + 512 + h * 128;
                    att::attn_core<2>(A, alds, o, rli);
                    int lq = lane_a; asm volatile("" : "+v"(lq));
                    bf16* Ob = MQ + (row0 + wave * 32 + 4 * (lq >> 5)) * 512 + h * 128 + (lq & 31);
#pragma unroll
                    for (int d = 0; d < 4; ++d)
#pragma unroll
                        for (int r = 0; r < 16; ++r) if (rep) Ob[att::crow(r, 0) * 512 + d * 32] = att::f2bf(o[d][r] * rli[r]);
                } }
#endif
            }
        }
        GRID_SYNC();
#if (PH_MASK & 64)
        {   const kparams_t kp = getp(); unsigned char* ws = kp->ws; bf16* Wb = WSP(bf16, WS_W); bf16 *XB = WSP(bf16, WS_XB), *GB = WSP(bf16, WS_G), *MG = WSP(bf16, WS_MG);
            pg8::StaticOrder S; S.init(T, 1024, G, bx); const float* bg = kp->b_gate + (size_t)l * 3 * 1024;
            {
            {   pg8::Gemm g{XB, Wb + WO_G, T, 1024, 1024, 1024, 1024}; pg8::EpiGate E{GB, bg};
                pg8::gemm_phase<pg8::EpiGate, pg8::StaticOrder, true, true>(lds, g, S, E); }
            {   pg8::Gemm g{WSP(bf16, WS_QM), Wb + WO_BM, T, 1024, 512, 768, 512}; pg8::EpiBranch<true> E{GB, MG};
                pg8::gemm_phase<pg8::EpiBranch<true>, pg8::StaticOrder, true, true>(lds, g, S, E); }
            {   pg8::Gemm g{XB, Wb + WO_G + (size_t)1024 * 1024, T, 1024, 1024, 1024, 1024}; pg8::EpiGate E{GB, bg + 1024};
                pg8::gemm_phase<pg8::EpiGate, pg8::StaticOrder, true, true>(lds, g, S, E); }
            {   pg8::Gemm g{WSP(bf16, WS_DQ), Wb + WO_BD, T, 1024, 1024, 1024, 1024}; pg8::EpiBranch<false> E{GB, MG};
                pg8::gemm_phase<pg8::EpiBranch<false>, pg8::StaticOrder, true, true>(lds, g, S, E); }
            {   pg8::Gemm g{XB, Wb + WO_G + (size_t)2048 * 1024, T, 1024, 1024, 1024, 1024}; pg8::EpiGate E{GB, bg + 2048};
                pg8::gemm_phase<pg8::EpiGate, pg8::StaticOrder, true, true>(lds, g, S, E); }
            {   pg8::Gemm g{WSP(bf16, WS_MQ), Wb + WO_BE, T, 1024, 512, 512, 512}; pg8::EpiBranch<false> E{GB, MG};
                pg8::gemm_phase<pg8::EpiBranch<false>, pg8::StaticOrder, true, true>(lds, g, S, E); } } }
        GRID_SYNC();
#endif
#if (PH_MASK & 128)
        {   const kparams_t kp = getp(); unsigned char* ws = kp->ws;
            pg8::Gemm g{WSP(bf16, WS_MG), WSP(bf16, WS_W) + WO_OUT, T, 1024, 1024, 1024, 1024}; pg8::StaticOrder S; S.init(T, 1024, G, bx); pg8::EpiRes E{kp->out, ALPHA};
            pg8::gemm_phase<pg8::EpiRes, pg8::StaticOrder, true, true>(lds, g, S, E); }
        GRID_SYNC();
#endif
        {   const kparams_t kp = getp(); unsigned char* ws = kp->ws;
            ln_rows(kp->out, WSP(bf16, WS_XB), kp->ln1g + l * DM, kp->ln1b + l * DM, gw, NGW, lane); }
        GRID_SYNC();
#if (PH_MASK & 256)
        {   const kparams_t kp = getp(); unsigned char* ws = kp->ws;
            pg8::Gemm g{WSP(bf16, WS_XB), WSP(bf16, WS_W) + WO_1, T, 4096, 1024, 1024, 1024}; pg8::StaticOrder S; S.init(T, 4096, G, bx); pg8::EpiRelu2 E{WSP(bf16, WS_HID), 4096};
            pg8::gemm_phase<pg8::EpiRelu2, pg8::StaticOrder, true, true>(lds, g, S, E); }
        GRID_SYNC();
#endif
#if (PH_MASK & 512)
        {   const kparams_t kp = getp(); unsigned char* ws = kp->ws;
            pg8::Gemm g{WSP(bf16, WS_HID), WSP(bf16, WS_W) + WO_2, T, 1024, 4096, 4096, 4096}; pg8::StaticOrder S; S.init(T, 1024, G, bx); pg8::EpiRes E{kp->out, ALPHA};
            pg8::gemm_phase<pg8::EpiRes, pg8::StaticOrder, true, true>(lds, g, S, E); }
        GRID_SYNC();
#endif
        {   const kparams_t kp = getp(); unsigned char* ws = kp->ws;
            ln_rows(kp->out, WSP(bf16, WS_XB), kp->ln2g + l * DM, kp->ln2b + l * DM, gw, NGW, lane); }
        if (l + 1 < DEPTH) { convert_weights(l + 1, lds, gw, NGW, wave, lane); GRID_SYNC(); }
    }
}

extern "C" void kernel_launch(void* const* d_in, const int* in_sizes, int n_in, void* d_out, int out_size, void* d_ws, size_t ws_size, hipStream_t stream) {
    static int grid = 0;
    if (grid == 0) {
        if (n_in != 20 || in_sizes[0] != T * DM || out_size != T * DM || ws_size < WS_END) {
            fprintf(stderr, "kernel_launch: unexpected shapes (n_in %d, in0 %d, out %d, ws %zu; need ws >= %zu); nothing launched\n", n_in, n_in > 0 ? in_sizes[0] : -1, out_size, ws_size, (size_t)WS_END); grid = -1; return; }
        int dev = 0, cus = 0, per_cu = 0;
        if (hipGetDevice(&dev) != hipSuccess || hipDeviceGetAttribute(&cus, hipDeviceAttributeMultiprocessorCount, dev) != hipSuccess) { grid = -1; return; }
        if (hipFuncSetAttribute((const void*)fwd_megakernel, hipFuncAttributeMaxDynamicSharedMemorySize, LDS_BYTES) != hipSuccess) { fprintf(stderr, "kernel_launch: hipFuncSetAttribute failed\n"); grid = -1; return; }
        if (hipOccupancyMaxActiveBlocksPerMultiprocessor(&per_cu, (const void*)fwd_megakernel, NTHREADS, LDS_BYTES) != hipSuccess || per_cu < 1) { fprintf(stderr, "kernel_launch: occupancy query says %d\n", per_cu); per_cu = 1; }
        (void)hipGetLastError();
        grid = cus * 1;
    }
    if (grid < 0) return;
    if (hipMemsetAsync((char*)d_ws + WS_BAR, 0, 256, stream) != hipSuccess) { fprintf(stderr, "kernel_launch: hipMemsetAsync failed\n"); return; }
    Params p{};
    p.x = (const float*)d_in[0]; p.mem = (const float*)d_in[1]; p.pos = (const int*)d_in[2];
    p.w_in = (const float*)d_in[3]; p.b_gate = (const float*)d_in[4]; p.q_norm = (const float*)d_in[5]; p.kv_norm = (const float*)d_in[6];
    p.w_uq = (const float*)d_in[7]; p.w_ukv = (const float*)d_in[8]; p.dlam = (const float*)d_in[9]; p.subln = (const float*)d_in[10];
    p.w_mkv = (const float*)d_in[11]; p.w_br = (const float*)d_in[12]; p.w_out = (const float*)d_in[13]; p.ln1g = (const float*)d_in[14]; p.ln1b = (const float*)d_in[15];
    p.w1 = (const float*)d_in[16]; p.w2 = (const float*)d_in[17]; p.ln2g = (const float*)d_in[18]; p.ln2b = (const float*)d_in[19];
    p.out = (float*)d_out; p.ws = (unsigned char*)d_ws;
    void* args[] = {&p};
    hipError_t e = hipLaunchCooperativeKernel((const void*)fwd_megakernel, dim3(grid), dim3(NTHREADS), args, LDS_BYTES, stream);
    if (e != hipSuccess) fprintf(stderr, "kernel_launch: cooperative launch failed: %s (grid %d)\n", hipGetErrorString(e), grid);
}
```

```cpp
#include <hip/hip_runtime.h>
#include <hip/hip_cooperative_groups.h>
#include <cstdio>
#include <cstdint>
#include <cmath>
namespace cg = cooperative_groups;

namespace pg8 {
#define PG8_LAS __attribute__((address_space(3)))
typedef unsigned short bf16_t;
typedef short bf16x8 __attribute__((ext_vector_type(8)));
typedef float f32x4 __attribute__((ext_vector_type(4)));
typedef unsigned u32x4 __attribute__((ext_vector_type(4)));
constexpr int BM = 256, BK = 64, HALF = 128, HTB = HALF * BK * 2  , STAGE_BYTES = 8 * HTB, NXCD = 8, WGM = 8;

__host__ __device__ __forceinline__ int lds_byte(int r, int c) { const int st = (r >> 4) * 2 + (c >> 5), rr = r & 15, cc = c & 31, ob = rr * 64 + cc * 2; return st * 1024 + (ob ^ (((ob >> 9) & 1) << 5)); }
__host__ __device__ __forceinline__ void stage_rc(int b, int& R, int& C) { const int st = b / 1024, sb = b % 1024, swz = sb ^ (((sb >> 9) & 1) << 5); R = (st >> 1) * 16 + swz / 64; C = (st & 1) * 32 + (swz % 64) / 2; }
__host__ __device__ __forceinline__ int perm32(int rho) { const int n = rho >> 4, i = rho & 15; return 8 * (i >> 2) + 4 * n + (i & 3); }

struct Unit { int pm, pn; };
struct Gemm { const bf16_t* A; const bf16_t* Bt; int M, N, K, lda, ldb; };

struct StaticOrder {
    int nM, nN, nwg, G, c;
    __host__ __device__ void init(int M, int N, int G_, int c_) { nM = M / BM; nN = N / BM; nwg = nM * nN; G = G_; c = c_; }
    __host__ __device__ bool next(int i, Unit& u) const {
        const long L = (long)i * G + c; if (L >= nwg) return false;
        int wgid = (int)L; { const int q = nwg / NXCD, r = nwg % NXCD, xcd = wgid % NXCD, off = wgid / NXCD; wgid = (xcd < r ? xcd * (q + 1) : r * (q + 1) + (xcd - r) * q) + off; }
        const int nig = WGM * nN, gid = wgid / nig, fm = gid * WGM, gsz = (nM - fm) < WGM ? (nM - fm) : WGM;
        u.pm = fm + ((wgid % nig) % gsz); u.pn = (wgid % nig) / gsz; return true;
    }
    __device__ __forceinline__ void a_ready(const Unit&) const {}
    __device__ __forceinline__ void done(const Unit&) const {}
};

__device__ __forceinline__ unsigned cvt_pk_bf16(float lo, float hi) { unsigned r; asm volatile("v_cvt_pk_bf16_f32 %0, %1, %2" : "=v"(r) : "v"(lo), "v"(hi)); return r; }
__device__ __forceinline__ u32x4 pack8(const f32x4 v0, const f32x4 v1) { u32x4 w; w.x = cvt_pk_bf16(v0[0], v0[1]); w.y = cvt_pk_bf16(v0[2], v0[3]); w.z = cvt_pk_bf16(v1[0], v1[1]); w.w = cvt_pk_bf16(v1[2], v1[3]); return w; }
__device__ __forceinline__ u32x4 ld16_l2(const bf16_t* p) { const unsigned long long* q = (const unsigned long long*)p; const unsigned long long a = __hip_atomic_load(q, __ATOMIC_RELAXED, __HIP_MEMORY_SCOPE_AGENT), b = __hip_atomic_load(q + 1, __ATOMIC_RELAXED, __HIP_MEMORY_SCOPE_AGENT);
    u32x4 r; r.x = (unsigned)a; r.y = (unsigned)(a >> 32); r.z = (unsigned)b; r.w = (unsigned)(b >> 32); return r; }
__device__ __forceinline__ void st16(void* p, const u32x4 w) { unsigned long long* q = (unsigned long long*)p;
    __hip_atomic_store(q, (unsigned long long)w.x | ((unsigned long long)w.y << 32), __ATOMIC_RELAXED, __HIP_MEMORY_SCOPE_SYSTEM);
    __hip_atomic_store(q + 1, (unsigned long long)w.z | ((unsigned long long)w.w << 32), __ATOMIC_RELAXED, __HIP_MEMORY_SCOPE_SYSTEM); }
__device__ __forceinline__ float sgm(float v) { return __builtin_amdgcn_rcpf(1.f + __expf(-v)); }
__device__ __forceinline__ float bflo(unsigned w) { return __uint_as_float(w << 16); }
__device__ __forceinline__ float bfhi(unsigned w) { return __uint_as_float(w & 0xffff0000u); }
__device__ __forceinline__ f32x4 shx4(const f32x4 v, int m) { f32x4 r; r[0] = __shfl_xor(v[0], m); r[1] = __shfl_xor(v[1], m); r[2] = __shfl_xor(v[2], m); r[3] = __shfl_xor(v[3], m); return r; }

struct EpiH {
    static constexpr bool PERM = true, AFTER_DRAIN = false;
    bf16_t *lat, *dq, *dk, *dv, *mq; const float *cosd, *sind, *cosm, *sinm;
    __device__ __forceinline__ void operator()(const f32x4 (&acc)[2][2][4][2], const Unit& u, int wr, int wc, int fr, int fq) const {
        const int pn = u.pn; bf16_t* base; int ld, c0, mode;
        if (pn < 3) { base = lat; ld = 768; c0 = pn * 256; mode = (pn == 2) ? 2 : 0; }
        else if (pn < 7) { base = dq; ld = 1024; c0 = (pn - 3) * 256; mode = 1; }
        else if (pn < 11) { base = dk; ld = 1024; c0 = (pn - 7) * 256; mode = 1; }
        else if (pn < 15) { base = dv; ld = 1024; c0 = (pn - 11) * 256; mode = 0; }
        else { base = mq; ld = 512; c0 = (pn - 15) * 256; mode = 0; }
        const int row0 = u.pm * BM + wr * 64 + fr, colw = c0 + wc * 32 + 8 * fq;
#pragma unroll
        for (int ai = 0; ai < 2; ++ai)
#pragma unroll
            for (int m = 0; m < 4; ++m) { const int row = row0 + ai * HALF + m * 16; bf16_t* rowp = base + (size_t)row * ld + colw;
#pragma unroll
                for (int bj = 0; bj < 2; ++bj) { f32x4 v0 = acc[ai][bj][m][0], v1 = acc[ai][bj][m][1];
                    if (mode == 1 && (wc & 1) == 0) {
                        const f32x4 p0 = shx4(v0, 16), p1 = shx4(v1, 16);
                        if (fq < 2) { const f32x4 c0v = *(const f32x4*)(cosd + (size_t)row * 8), c1v = *(const f32x4*)(cosd + (size_t)row * 8 + 4);
                            f32x4 s0v = *(const f32x4*)(sind + (size_t)row * 8), s1v = *(const f32x4*)(sind + (size_t)row * 8 + 4);
                            if (fq == 0) { s0v = -s0v; s1v = -s1v; }
                            v0 = v0 * c0v + p0 * s0v; v1 = v1 * c1v + p1 * s1v; } }
                    if (mode == 2 && bj == 1 && wc == 0) {
                        const f32x4 p0 = shx4(v0, 32), p1 = shx4(v1, 32); const int i16 = (fq & 1) * 8;
                        const f32x4 c0v = *(const f32x4*)(cosm + (size_t)row * 16 + i16), c1v = *(const f32x4*)(cosm + (size_t)row * 16 + i16 + 4);
                        f32x4 s0v = *(const f32x4*)(sinm + (size_t)row * 16 + i16), s1v = *(const f32x4*)(sinm + (size_t)row * 16 + i16 + 4);
                        if (fq < 2) { s0v = -s0v; s1v = -s1v; }
                        v0 = v0 * c0v + p0 * s0v; v1 = v1 * c1v + p1 * s1v; }
                    *(u32x4*)(rowp + bj * HALF) = pack8(v0, v1); }
                asm volatile("" ::: "memory"); }
    }
};
template <bool ROPE> struct EpiScale {
    static constexpr bool PERM = true, AFTER_DRAIN = false;
    bf16_t* O; int ld; const float* rs; const float *cosm, *sinm;
    __device__ __forceinline__ void operator()(const f32x4 (&acc)[2][2][4][2], const Unit& u, int wr, int wc, int fr, int fq) const {
        const int row0 = u.pm * BM + wr * 64 + fr, colw = u.pn * BM + wc * 32 + 8 * fq;
#pragma unroll
        for (int ai = 0; ai < 2; ++ai)
#pragma unroll
            for (int m = 0; m < 4; ++m) { const int row = row0 + ai * HALF + m * 16; bf16_t* rowp = O + (size_t)row * ld + colw;
                const float sc = rs ? __hip_atomic_load(rs + row, __ATOMIC_RELAXED, __HIP_MEMORY_SCOPE_AGENT) : 1.f;
#pragma unroll
                for (int bj = 0; bj < 2; ++bj) { f32x4 v0 = acc[ai][bj][m][0] * sc, v1 = acc[ai][bj][m][1] * sc;
                    if (ROPE && u.pn == 2) {
                        const f32x4 p0 = shx4(v0, 32), p1 = shx4(v1, 32); const int i16 = (fq & 1) * 8;
                        const f32x4 c0v = *(const f32x4*)(cosm + (size_t)row * 16 + i16), c1v = *(const f32x4*)(cosm + (size_t)row * 16 + i16 + 4);
                        f32x4 s0v = *(const f32x4*)(sinm + (size_t)row * 16 + i16), s1v = *(const f32x4*)(sinm + (size_t)row * 16 + i16 + 4);
                        if (fq < 2) { s0v = -s0v; s1v = -s1v; }
                        v0 = v0 * c0v + p0 * s0v; v1 = v1 * c1v + p1 * s1v; }
                    *(u32x4*)(rowp + bj * HALF) = pack8(v0, v1); }
                asm volatile("" ::: "memory"); }
    }
};
struct EpiGate {
    static constexpr bool PERM = true, AFTER_DRAIN = false;
    bf16_t* G; const float* bias;
    __device__ __forceinline__ void operator()(const f32x4 (&acc)[2][2][4][2], const Unit& u, int wr, int wc, int fr, int fq) const {
        const int row0 = u.pm * BM + wr * 64 + fr, colw = u.pn * BM + wc * 32 + 8 * fq;
        f32x4 bv[2][2];
#pragma unroll
        for (int bj = 0; bj < 2; ++bj)
#pragma unroll
            for (int n = 0; n < 2; ++n) bv[bj][n] = *(const f32x4*)(bias + colw + bj * HALF + 4 * n);
#pragma unroll
        for (int ai = 0; ai < 2; ++ai)
#pragma unroll
            for (int m = 0; m < 4; ++m) { bf16_t* rowp = G + (size_t)(row0 + ai * HALF + m * 16) * 1024 + colw;
#pragma unroll
                for (int bj = 0; bj < 2; ++bj) { f32x4 v0 = acc[ai][bj][m][0] + bv[bj][0], v1 = acc[ai][bj][m][1] + bv[bj][1];
                    *(u32x4*)(rowp + bj * HALF) = pack8(v0, v1); }
                asm volatile("" ::: "memory"); }
    }
};
template <bool FIRST> struct EpiBranch {
    static constexpr bool PERM = true, AFTER_DRAIN = false;
    const bf16_t* G; bf16_t* Mg;
    __device__ __forceinline__ void operator()(const f32x4 (&acc)[2][2][4][2], const Unit& u, int wr, int wc, int fr, int fq) const {
        const int row0 = u.pm * BM + wr * 64 + fr, colw = u.pn * BM + wc * 32 + 8 * fq;
#pragma unroll
        for (int ai = 0; ai < 2; ++ai)
#pragma unroll
            for (int m = 0; m < 4; ++m) { const size_t off = (size_t)(row0 + ai * HALF + m * 16) * 1024 + colw;
#pragma unroll
                for (int bj = 0; bj < 2; ++bj) { const u32x4 g = *(const u32x4*)(G + off + bj * HALF);
                    f32x4 v0 = acc[ai][bj][m][0], v1 = acc[ai][bj][m][1];
                    v0[0] *= sgm(bflo(g.x)); v0[1] *= sgm(bfhi(g.x)); v0[2] *= sgm(bflo(g.y)); v0[3] *= sgm(bfhi(g.y)); v1[0] *= sgm(bflo(g.z)); v1[1] *= sgm(bfhi(g.z)); v1[2] *= sgm(bflo(g.w)); v1[3] *= sgm(bfhi(g.w));
                    if (!FIRST) { const u32x4 o = *(const u32x4*)(Mg + off + bj * HALF);
                        v0[0] += bflo(o.x); v0[1] += bfhi(o.x); v0[2] += bflo(o.y); v0[3] += bfhi(o.y); v1[0] += bflo(o.z); v1[1] += bfhi(o.z); v1[2] += bflo(o.w); v1[3] += bfhi(o.w); }
                    *(u32x4*)(Mg + off + bj * HALF) = pack8(v0, v1); }
                asm volatile("" ::: "memory"); }
    }
};
struct EpiRes {
    static constexpr bool PERM = false, AFTER_DRAIN = false;
    float* X; float alpha;
    __device__ __forceinline__ void operator()(const f32x4 (&acc)[2][2][4][2], const Unit& u, int wr, int wc, int fr, int fq) const {
        const int row0 = u.pm * BM + wr * 64 + fr, col0 = u.pn * BM + wc * 32 + 4 * fq;
        float* base = X + (size_t)row0 * 1024 + col0;
        f32x4 xq[2][2][2];
#pragma unroll
        for (int bj = 0; bj < 2; ++bj)
#pragma unroll
            for (int n = 0; n < 2; ++n) xq[0][bj][n] = *(const f32x4*)(base + bj * HALF + n * 16);
#pragma unroll
        for (int it = 0; it < 8; ++it) { const int ai = it >> 2, m = it & 3, cur = it & 1; float* rowp = base + (size_t)(ai * HALF + m * 16) * 1024;
            if (it < 7) { const float* rown = base + (size_t)(((it + 1) >> 2) * HALF + ((it + 1) & 3) * 16) * 1024;
#pragma unroll
                for (int bj = 0; bj < 2; ++bj)
#pragma unroll
                    for (int n = 0; n < 2; ++n) xq[cur ^ 1][bj][n] = *(const f32x4*)(rown + bj * HALF + n * 16); }
#pragma unroll
            for (int bj = 0; bj < 2; ++bj)
#pragma unroll
                for (int n = 0; n < 2; ++n) *(f32x4*)(rowp + bj * HALF + n * 16) = xq[cur][bj][n] * alpha + acc[ai][bj][m][n];
            asm volatile("" ::: "memory"); }
    }
};
struct EpiRelu2 {
    static constexpr bool PERM = true, AFTER_DRAIN = false;
    bf16_t* H; int ld;
    __device__ __forceinline__ void operator()(const f32x4 (&acc)[2][2][4][2], const Unit& u, int wr, int wc, int fr, int fq) const {
        const int row0 = u.pm * BM + wr * 64 + fr, colw = u.pn * BM + wc * 32 + 8 * fq;
#pragma unroll
        for (int ai = 0; ai < 2; ++ai)
#pragma unroll
            for (int m = 0; m < 4; ++m) { bf16_t* rowp = H + (size_t)(row0 + ai * HALF + m * 16) * ld + colw;
#pragma unroll
                for (int bj = 0; bj < 2; ++bj) { f32x4 v0 = acc[ai][bj][m][0], v1 = acc[ai][bj][m][1];
#pragma unroll
                    for (int e = 0; e < 4; ++e) { const float a = fmaxf(v0[e], 0.f), b = fmaxf(v1[e], 0.f); v0[e] = a * a; v1[e] = b * b; }
                    *(u32x4*)(rowp + bj * HALF) = pack8(v0, v1); }
                asm volatile("" ::: "memory"); }
    }
};

template <class Epi, class Sched, bool ALIGN_EPI = false, bool SP2 = false>
__device__ __forceinline__ void gemm_phase(PG8_LAS unsigned char* lds, const Gemm g, const Sched& S, const Epi& E) {
    int tid_ = threadIdx.x; asm volatile("" : "+v"(tid_));
    const int tid = tid_, wid = __builtin_amdgcn_readfirstlane(tid >> 6), lane = tid & 63, wr = wid >> 2, wc = wid & 3, fr = lane & 15, fq = lane >> 4;
    int K_ = g.K; asm volatile("" : "+s"(K_));
    const int K = K_, nt = K / BK;
    unsigned voffA[2], voffB[2];
#pragma unroll
    for (int i = 0; i < 2; ++i) { int R, C; stage_rc(tid * 16 + i * 8192, R, C); const int Rb = Epi::PERM ? ((R & ~31) + perm32(R & 31)) : R;
        voffA[i] = (unsigned)(R * g.lda + C) * 2u; voffB[i] = (unsigned)(Rb * g.ldb + C) * 2u; }
    const size_t kstep = (size_t)(BK * 2);
    const size_t hstepA = (size_t)HALF * g.lda * 2, hstepB = (size_t)HALF * g.ldb * 2;
    const size_t tstepA = 2 * hstepA, tstepB = 2 * hstepB;
    const unsigned ldsw = (unsigned)wid * 1024u;
    const int aoff = lds_byte(wr * 64 + fr, fq * 8), boff = lds_byte(wc * 32 + fr, fq * 8);
#define PG8_SA(b, h) (((b) * 2 + (h)) * HTB)
#define PG8_SB(b, h) ((4 + (b) * 2 + (h)) * HTB)
#define PG8_STAGE(bufoff, gbase, voff) do { _Pragma("unroll") for (int _i = 0; _i < 2; ++_i) \
        __builtin_amdgcn_global_load_lds((const unsigned*)((const char*)(gbase) + (voff)[_i]), (PG8_LAS unsigned*)(lds + (bufoff) + ldsw + _i * 8192), 16, 0, 0); } while (0)
#define PG8_LDA(dst, b, h) do { _Pragma("unroll") for (int m = 0; m < 4; ++m) _Pragma("unroll") for (int k = 0; k < 2; ++k) dst[m][k] = *(const PG8_LAS bf16x8*)(lds + PG8_SA(b, h) + aoff + m * 2048 + k * 1024); } while (0)
#define PG8_LDB(dst, b, h) do { _Pragma("unroll") for (int n = 0; n < 2; ++n) _Pragma("unroll") for (int k = 0; k < 2; ++k) dst[n][k] = *(const PG8_LAS bf16x8*)(lds + PG8_SB(b, h) + boff + n * 2048 + k * 1024); } while (0)
#define PG8_MMA(ai, bj, At, Bt) do { __builtin_amdgcn_s_setprio(1); _Pragma("unroll") for (int m = 0; m < 4; ++m) _Pragma("unroll") for (int n = 0; n < 2; ++n) _Pragma("unroll") for (int k = 0; k < 2; ++k) \
        acc[ai][bj][m][n] = __builtin_amdgcn_mfma_f32_16x16x32_bf16(Bt[n][k], At[m][k], acc[ai][bj][m][n], 0, 0, 0); __builtin_amdgcn_s_setprio(0); } while (0)
#define PG8_WAIT_V(n) asm volatile("s_waitcnt vmcnt(" #n ")" ::: "memory")
#define PG8_WAIT_L(n) asm volatile("s_waitcnt lgkmcnt(" #n ")" ::: "memory")
#define PG8_BAR __builtin_amdgcn_s_barrier()
#define PG8_SCHED __builtin_amdgcn_sched_barrier(0)
    Unit cur, nxt; int ui = 0;
    if (!S.next(0, cur)) return;
    f32x4 acc[2][2][4][2];
#pragma unroll
    for (int a = 0; a < 2; ++a)
#pragma unroll
        for (int b = 0; b < 2; ++b)
#pragma unroll
            for (int m = 0; m < 4; ++m)
#pragma unroll
                for (int n = 0; n < 2; ++n) acc[a][b][m][n] = (f32x4){0.f, 0.f, 0.f, 0.f};
    bf16x8 At[4][2], B0[2][2], B1[2][2];
    const char* cA = (const char*)g.A + (size_t)cur.pm * tstepA; const char* cB = (const char*)g.Bt + (size_t)cur.pn * tstepB;
    S.a_ready(cur);
    if constexpr (SP2) {
        PG8_STAGE(PG8_SB(0, 0), cB, voffB); PG8_STAGE(PG8_SB(0, 1), cB + hstepB, voffB); PG8_STAGE(PG8_SA(0, 0), cA, voffA); PG8_STAGE(PG8_SA(0, 1), cA + hstepA, voffA);
        if (wr == 1) PG8_BAR;
        PG8_WAIT_V(2); PG8_BAR;
        PG8_STAGE(PG8_SB(1, 0), cB + kstep, voffB); PG8_STAGE(PG8_SA(1, 0), cA + kstep, voffA); PG8_STAGE(PG8_SB(1, 1), cB + hstepB + kstep, voffB);
        PG8_WAIT_V(6); PG8_BAR;
    } else {
        PG8_STAGE(PG8_SB(0, 0), cB, voffB); PG8_STAGE(PG8_SA(0, 0), cA, voffA); PG8_STAGE(PG8_SB(0, 1), cB + hstepB, voffB); PG8_STAGE(PG8_SA(0, 1), cA + hstepA, voffA);
        if (wr == 1) PG8_BAR;
        PG8_WAIT_V(4); PG8_BAR;
        PG8_STAGE(PG8_SB(1, 0), cB + kstep, voffB); PG8_STAGE(PG8_SA(1, 0), cA + kstep, voffA); PG8_STAGE(PG8_SB(1, 1), cB + hstepB + kstep, voffB);
        PG8_WAIT_V(6); PG8_BAR;
    }
    for (;;) {
        const bool has_next = S.next(ui + 1, nxt);
        const char* nA = has_next ? (const char*)g.A + (size_t)nxt.pm * tstepA : cA; const char* nB = has_next ? (const char*)g.Bt + (size_t)nxt.pn * tstepB : cB;
        for (int t = 0; t < nt; t += 2) {
            const bool last = (t == nt - 2);
            const char* a1 = cA + (size_t)(t + 1) * kstep;
            const char* a2 = last ? nA : cA + (size_t)(t + 2) * kstep; const char* b2 = last ? nB : cB + (size_t)(t + 2) * kstep;
            const char* a3 = a2 + kstep; const char* b3 = b2 + kstep;
            if (last && has_next) S.a_ready(nxt);
            if constexpr (SP2) {
            PG8_LDB(B0, 0, 0); PG8_LDB(B1, 0, 1); PG8_SCHED; PG8_LDA(At, 0, 0); PG8_STAGE(PG8_SA(1, 1), a1 + hstepA, voffA);
            PG8_WAIT_V(8); PG8_WAIT_L(0); PG8_BAR; PG8_MMA(0, 0, At, B0); PG8_MMA(0, 1, At, B1); PG8_BAR; PG8_SCHED;
            PG8_LDA(At, 0, 1); PG8_STAGE(PG8_SB(0, 0), b2, voffB); PG8_STAGE(PG8_SB(0, 1), b2 + hstepB, voffB); PG8_STAGE(PG8_SA(0, 0), a2, voffA);
            PG8_WAIT_V(8); PG8_WAIT_L(0); PG8_BAR; PG8_MMA(1, 0, At, B0); PG8_MMA(1, 1, At, B1); PG8_BAR; PG8_SCHED;
            PG8_LDB(B0, 1, 0); PG8_LDB(B1, 1, 1); PG8_SCHED; PG8_LDA(At, 1, 0); PG8_STAGE(PG8_SA(0, 1), a2 + hstepA, voffA);
            PG8_WAIT_V(8); PG8_WAIT_L(0); PG8_BAR; PG8_MMA(0, 0, At, B0); PG8_MMA(0, 1, At, B1); PG8_BAR; PG8_SCHED;
            PG8_LDA(At, 1, 1); PG8_STAGE(PG8_SB(1, 0), b3, voffB); PG8_STAGE(PG8_SB(1, 1), b3 + hstepB, voffB); PG8_STAGE(PG8_SA(1, 0), a3, voffA);
            PG8_WAIT_V(8); PG8_WAIT_L(0); PG8_BAR; PG8_MMA(1, 0, At, B0); PG8_MMA(1, 1, At, B1); PG8_BAR; PG8_SCHED;
            } else {
            PG8_LDB(B0, 0, 0); PG8_SCHED; PG8_LDA(At, 0, 0); PG8_STAGE(PG8_SA(1, 1), a1 + hstepA, voffA);
            PG8_WAIT_L(8); PG8_BAR; PG8_WAIT_L(0); PG8_MMA(0, 0, At, B0); PG8_BAR; PG8_SCHED;
            PG8_LDB(B1, 0, 1); PG8_STAGE(PG8_SB(0, 0), b2, voffB);
            PG8_BAR; PG8_WAIT_L(0); PG8_MMA(0, 1, At, B1); PG8_BAR;
            PG8_LDA(At, 0, 1); PG8_STAGE(PG8_SA(0, 0), a2, voffA);
            PG8_BAR; PG8_WAIT_L(0); PG8_MMA(1, 0, At, B0); PG8_BAR; PG8_SCHED;
            PG8_STAGE(PG8_SB(0, 1), b2 + hstepB, voffB);
            PG8_WAIT_V(6); PG8_BAR; PG8_MMA(1, 1, At, B1); PG8_BAR;
            PG8_LDB(B0, 1, 0); PG8_SCHED; PG8_LDA(At, 1, 0); PG8_STAGE(PG8_SA(0, 1), a2 + hstepA, voffA);
            PG8_WAIT_L(8); PG8_BAR; PG8_WAIT_L(0); PG8_MMA(0, 0, At, B0); PG8_BAR; PG8_SCHED;
            PG8_LDB(B1, 1, 1); PG8_STAGE(PG8_SB(1, 0), b3, voffB);
            PG8_BAR; PG8_WAIT_L(0); PG8_MMA(0, 1, At, B1); PG8_BAR;
            PG8_LDA(At, 1, 1); PG8_STAGE(PG8_SA(1, 0), a3, voffA);
            PG8_BAR; PG8_WAIT_L(0); PG8_MMA(1, 0, At, B0); PG8_BAR; PG8_SCHED;
            PG8_STAGE(PG8_SB(1, 1), b3 + hstepB, voffB);
            PG8_WAIT_V(6); PG8_BAR; PG8_MMA(1, 1, At, B1); PG8_BAR;
            }
        }
        if constexpr (ALIGN_EPI) { if (wr == 0) PG8_BAR; }
        if constexpr (!Epi::AFTER_DRAIN) { E(acc, cur, wr, wc, fr, fq); S.done(cur); }
        if (!has_next) break;
#pragma unroll
        for (int a = 0; a < 2; ++a)
#pragma unroll
            for (int b = 0; b < 2; ++b)
#pragma unroll
                for (int m = 0; m < 4; ++m)
#pragma unroll
                    for (int n = 0; n < 2; ++n) acc[a][b][m][n] = (f32x4){0.f, 0.f, 0.f, 0.f};
        cur = nxt; cA = nA; cB = nB; ++ui;
        if constexpr (ALIGN_EPI) { if (wr == 1) PG8_BAR; }
    }
    PG8_WAIT_V(0);
    if constexpr (!ALIGN_EPI) { if (wr == 0) PG8_BAR; }
    PG8_BAR;
    if constexpr (Epi::AFTER_DRAIN) { E.fused(acc, cur, wr, wc, fr, fq, lds, wid, lane); S.done(cur); }
#undef PG8_SA
#undef PG8_SB
#undef PG8_STAGE
#undef PG8_LDA
#undef PG8_LDB
#undef PG8_MMA
#undef PG8_WAIT_V
#undef PG8_WAIT_L
#undef PG8_BAR
#undef PG8_SCHED
}
}

namespace att {
#define LAS __attribute__((address_space(3)))
typedef unsigned short bf16_t;
typedef LAS char* lptr;
using bf16x8 = __attribute__((ext_vector_type(8))) short;
using s16x4  = __attribute__((ext_vector_type(4))) short;
using f32x16 = __attribute__((ext_vector_type(16))) float;
using u32x4  = __attribute__((ext_vector_type(4))) unsigned;
constexpr int V_OFF = 0, K_OFF = 32768, WS_OFF = 67584, STASH_OFF = 69632, ATT_LDS_END = STASH_OFF + 65536;
#define SBAR() __builtin_amdgcn_sched_barrier(0)
__device__ __forceinline__ int crow(int r, int hi) { return (r & 3) + 8 * (r >> 2) + 4 * hi; }
__device__ __forceinline__ unsigned cvtpk(float lo, float hi) { unsigned r; asm volatile("v_cvt_pk_bf16_f32 %0, %1, %2" : "=v"(r) : "v"(lo), "v"(hi)); return r; }
__device__ __forceinline__ unsigned short f2bf(float f) { unsigned u = __builtin_bit_cast(unsigned, f); return (unsigned short)((u + 0x7fffu + ((u >> 16) & 1u)) >> 16); }

struct Args { const bf16_t *Q0, *Q1, *K0, *K1, *V; int ldq, ldk0, ldk1, ldv, nkeys; float C, thr; };

__device__ __forceinline__ void partialSM(f32x16& p0, f32x16& p1, float& m_reg, float& mn, float& alpha, float C, float thr) {
  float pmax = p0[0];
#pragma unroll
  for (int r = 1; r < 16; ++r) pmax = fmaxf(pmax, p0[r]);
#pragma unroll
  for (int r = 0; r < 16; ++r) pmax = fmaxf(pmax, p1[r]);
  { auto rr = __builtin_amdgcn_permlane32_swap(__float_as_uint(pmax), __float_as_uint(pmax), false, false);
    pmax = fmaxf(__uint_as_float(rr[0]), __uint_as_float(rr[1])); }
  if (__builtin_expect(__all(pmax - m_reg <= thr), 1)) { mn = m_reg; alpha = 1.f; }
  else { mn = fmaxf(m_reg, pmax); alpha = __builtin_amdgcn_exp2f((m_reg - mn) * C); m_reg = mn; }
  const float mnC = -mn * C;
#pragma unroll
  for (int r = 0; r < 16; ++r) p0[r] = fmaf(p0[r], C, mnC);
#pragma unroll
  for (int r = 0; r < 16; ++r) p1[r] = fmaf(p1[r], C, mnC);
#pragma unroll
  for (int r = 0; r < 16; ++r) p0[r] = __builtin_amdgcn_exp2f(p0[r]);
}
__device__ __forceinline__ void finishSM(f32x16& p0, f32x16& p1, float alpha, float& l_reg, bf16x8& pa0, bf16x8& pa1, bf16x8& pa2, bf16x8& pa3) {
#pragma unroll
  for (int r = 0; r < 16; ++r) p1[r] = __builtin_amdgcn_exp2f(p1[r]);
  float ps = 0;
#pragma unroll
  for (int r = 0; r < 16; ++r) ps += p0[r];
#pragma unroll
  for (int r = 0; r < 16; ++r) ps += p1[r];
  { auto rr = __builtin_amdgcn_permlane32_swap(__float_as_uint(ps), __float_as_uint(ps), false, false);
    ps = __uint_as_float(rr[0]) + __uint_as_float(rr[1]); }
  l_reg = l_reg * alpha + ps;
#define PK4(P, BASE, OUT) do { unsigned a0 = cvtpk(P[BASE + 0], P[BASE + 1]), a1 = cvtpk(P[BASE + 2], P[BASE + 3]);   \
    unsigned b0 = cvtpk(P[BASE + 4], P[BASE + 5]), b1 = cvtpk(P[BASE + 6], P[BASE + 7]);                              \
    auto r0 = __builtin_amdgcn_permlane32_swap(a0, b0, false, false); auto r1 = __builtin_amdgcn_permlane32_swap(a1, b1, false, false); \
    u32x4 w = {r0[0], r1[0], r0[1], r1[1]}; OUT = __builtin_bit_cast(bf16x8, w); } while (0)
  PK4(p0, 0, pa0); PK4(p0, 8, pa1); PK4(p1, 0, pa2); PK4(p1, 8, pa3);
#undef PK4
}
template <int NQ, int KROW> __device__ __forceinline__ void qkt(f32x16& p0, f32x16& p1, lptr Ks, const bf16x8* qr, int r32, int hi) {
  p0 = f32x16{}; p1 = f32x16{};
#pragma unroll
  for (int d0 = 0; d0 < NQ; ++d0) { const int cb = (d0 * 16 + hi * 8) * 2;
    const bf16x8 b0 = *(const LAS bf16x8*)(Ks + r32 * KROW + cb);
    const bf16x8 b1 = *(const LAS bf16x8*)(Ks + (32 + r32) * KROW + cb);
    p0 = __builtin_amdgcn_mfma_f32_32x32x16_bf16(b0, qr[d0], p0, 0, 0, 0);
    p1 = __builtin_amdgcn_mfma_f32_32x32x16_bf16(b1, qr[d0], p1, 0, 0, 0); }
}
template <int ND> __device__ __forceinline__ int v_st(int k, int c) { const int kk = (k & ~0xC) | ((k & 4) << 1) | ((k & 8) >> 1); return ((kk >> 3) * ND + (c >> 5)) * 512 + ((kk & 7) * 32 + (c & 31)) * 2; }
__device__ __forceinline__ int v_rd_base(int lane) { return ((lane & 3) << 3) | (((lane >> 2) & 3) << 6) | (((lane >> 4) & 1) << 5) | (((lane >> 5) & 1) << 8); }
template <int OFF> __device__ __forceinline__ s16x4 tr_read(int vb) {
  s16x4 r; asm volatile("ds_read_b64_tr_b16 %0, %1 offset:%2" : "=&v"(r) : "v"(vb), "i"(OFF) : "memory"); return r;
}
template <int ND, int D0> __device__ __forceinline__ void pv_one(f32x16& od, int vb, bf16x8 pa0, bf16x8 pa1, bf16x8 pa2, bf16x8 pa3) {
  constexpr int KG = ND * 512;
  const s16x4 l0 = tr_read<D0 * 512 + 0 * KG>(vb), h0 = tr_read<D0 * 512 + 1 * KG>(vb), l1 = tr_read<D0 * 512 + 2 * KG>(vb), h1 = tr_read<D0 * 512 + 3 * KG>(vb);
  const s16x4 l2 = tr_read<D0 * 512 + 4 * KG>(vb), h2 = tr_read<D0 * 512 + 5 * KG>(vb), l3 = tr_read<D0 * 512 + 6 * KG>(vb), h3 = tr_read<D0 * 512 + 7 * KG>(vb);
  asm volatile("s_waitcnt lgkmcnt(0)" ::: "memory"); SBAR();
#define PK(L, H) (bf16x8){L[0], L[1], L[2], L[3], H[0], H[1], H[2], H[3]}
  od = __builtin_amdgcn_mfma_f32_32x32x16_bf16(pa0, PK(l0, h0), od, 0, 0, 0);
  od = __builtin_amdgcn_mfma_f32_32x32x16_bf16(pa1, PK(l1, h1), od, 0, 0, 0);
  od = __builtin_amdgcn_mfma_f32_32x32x16_bf16(pa2, PK(l2, h2), od, 0, 0, 0);
  od = __builtin_amdgcn_mfma_f32_32x32x16_bf16(pa3, PK(l3, h3), od, 0, 0, 0);
#undef PK
}
template <int ND> __device__ __forceinline__ void pv_all(f32x16* o, int vb, bf16x8 pa0, bf16x8 pa1, bf16x8 pa2, bf16x8 pa3) {
  pv_one<ND, 0>(o[0], vb, pa0, pa1, pa2, pa3); pv_one<ND, 1>(o[1], vb, pa0, pa1, pa2, pa3);
  if constexpr (ND == 4) { pv_one<ND, 2>(o[2], vb, pa0, pa1, pa2, pa3); pv_one<ND, 3>(o[3], vb, pa0, pa1, pa2, pa3); }
}

template <int MODE> struct Cfg;
template <> struct Cfg<0> { static constexpr int DQK = 96, DV = 64; };
template <> struct Cfg<1> { static constexpr int DQK = 64, DV = 128; };
template <> struct Cfg<2> { static constexpr int DQK = 128, DV = 128; };

struct Slot { bf16x8 a, b, c, d; };

template <int MODE>
__device__ __forceinline__ void attn_core(const Args& A, lptr lds, f32x16* o, float* rli) {
  constexpr int DQK = Cfg<MODE>::DQK, DV = Cfg<MODE>::DV, NQ = DQK / 16, ND = DV / 32, KROW = DQK * 2 + 16, SHM_K = 64 * KROW, SHM_V = 64 * DV * 2;
  int tid_ = threadIdx.x; asm volatile("" : "+v"(tid_));
  const int tid = tid_, wid = tid >> 6, lane = tid & 63, r32 = lane & 31, hi = lane >> 5;
  const lptr V_lds = lds + V_OFF, K_lds = lds + K_OFF;
  LAS float* ws = (LAS float*)(lds + WS_OFF) + wid * 64; LAS float* li_l = ws; LAS float* al_l = ws + 32;
  float m_reg = -1e30f, l_reg = 0.f;
#pragma unroll
  for (int d = 0; d < ND; ++d) o[d] = f32x16{};
  bf16x8 qr[NQ];
  { const bf16_t* Qw = A.Q0 + (size_t)(wid * 32 + r32) * A.ldq + hi * 8;
    if constexpr (MODE == 0) {
#pragma unroll
      for (int d0 = 0; d0 < 4; ++d0) qr[d0] = *(const bf16x8*)(Qw + d0 * 16);
      const bf16_t* Qw1 = A.Q1 + (size_t)(wid * 32 + r32) * A.ldq + hi * 8;
      qr[4] = *(const bf16x8*)(Qw1); qr[5] = *(const bf16x8*)(Qw1 + 16);
    } else {
#pragma unroll
      for (int d0 = 0; d0 < NQ; ++d0) qr[d0] = *(const bf16x8*)(Qw + d0 * 16);
    } }
  const int vb0 = (int)(uintptr_t)V_lds + v_rd_base(lane);
  Slot sr_[2];
  const int r8 = tid >> 3, c8 = (tid & 7) * 8;
  const int r16 = tid >> 4, c16 = (tid & 15) * 8;
  const int rr4 = (tid & 255) >> 2, cr4 = (tid & 3) * 8;
#define SLOAD(i, k0) do { \
    if constexpr (MODE == 0) { sr_[i].a = *(const bf16x8*)(A.K0 + (size_t)((k0) + r8) * A.ldk0 + c8); sr_[i].b = *(const bf16x8*)(A.K1 + (size_t)((k0) + rr4) * A.ldk1 + cr4); \
                               sr_[i].c = *(const bf16x8*)(A.V + (size_t)((k0) + r8) * A.ldv + c8); } \
    else if constexpr (MODE == 1) { sr_[i].a = *(const bf16x8*)(A.K0 + (size_t)((k0) + r8) * A.ldk0 + c8); \
                               sr_[i].c = *(const bf16x8*)(A.V + (size_t)((k0) + r16) * A.ldv + c16); sr_[i].d = *(const bf16x8*)(A.V + (size_t)((k0) + 32 + r16) * A.ldv + c16); } \
    else { sr_[i].a = *(const bf16x8*)(A.K0 + (size_t)((k0) + r16) * A.ldk0 + c16); sr_[i].b = *(const bf16x8*)(A.K0 + (size_t)((k0) + 32 + r16) * A.ldk0 + c16); \
           sr_[i].c = *(const bf16x8*)(A.V + (size_t)((k0) + r16) * A.ldv + c16); sr_[i].d = *(const bf16x8*)(A.V + (size_t)((k0) + 32 + r16) * A.ldv + c16); } } while (0)
#define SWRITE(bf, i) do { const lptr Kb = K_lds + (bf) * SHM_K; const lptr Vb = V_lds + (bf) * SHM_V; \
    if constexpr (MODE == 0) { *(LAS bf16x8*)(Kb + r8 * KROW + c8 * 2) = sr_[i].a; if (tid < 256) *(LAS bf16x8*)(Kb + rr4 * KROW + 128 + cr4 * 2) = sr_[i].b; \
                               *(LAS bf16x8*)(Vb + v_st<ND>(r8, c8)) = sr_[i].c; } \
    else if constexpr (MODE == 1) { *(LAS bf16x8*)(Kb + r8 * KROW + c8 * 2) = sr_[i].a; \
                               *(LAS bf16x8*)(Vb + v_st<ND>(r16, c16)) = sr_[i].c; *(LAS bf16x8*)(Vb + v_st<ND>(32 + r16, c16)) = sr_[i].d; } \
    else { *(LAS bf16x8*)(Kb + r16 * KROW + c16 * 2) = sr_[i].a; *(LAS bf16x8*)(Kb + (32 + r16) * KROW + c16 * 2) = sr_[i].b; \
           *(LAS bf16x8*)(Vb + v_st<ND>(r16, c16)) = sr_[i].c; *(LAS bf16x8*)(Vb + v_st<ND>(32 + r16, c16)) = sr_[i].d; } } while (0)
#define SWAIT() do { if constexpr (MODE == 2) asm volatile("s_waitcnt vmcnt(4)" ::: "memory"); else asm volatile("s_waitcnt vmcnt(3)" ::: "memory"); } while (0)
#define ATT_BAR() asm volatile("s_waitcnt lgkmcnt(0)\n\ts_barrier" ::: "memory")
#define RESC(a) do { if (__any((a) < 1.f)) { if (hi == 0) al_l[r32] = (a); asm volatile("s_waitcnt lgkmcnt(0)" ::: "memory"); \
    _Pragma("unroll") for (int d = 0; d < ND; ++d) _Pragma("unroll") for (int r = 0; r < 16; ++r) o[d][r] *= al_l[crow(r, hi)]; } } while (0)
  f32x16 pA0, pA1, pB0, pB1; float mnA, mnB, alA, alB; bf16x8 pa0, pa1, pa2, pa3; const int NT = A.nkeys / 64;
  const float C = A.C, thr = A.thr;
  SLOAD(0, 0); asm volatile("s_waitcnt vmcnt(0)" ::: "memory"); SWRITE(0, 0); ATT_BAR();
  qkt<NQ, KROW>(pA0, pA1, K_lds, qr, r32, hi); partialSM(pA0, pA1, m_reg, mnA, alA, C, thr);
  SLOAD(1, 64); if (2 < NT) SLOAD(0, 128);
  SWAIT(); SWRITE(1, 1); ATT_BAR();
  for (int j = 1; j + 1 < NT; j += 2) {
    SBAR(); qkt<NQ, KROW>(pB0, pB1, K_lds + SHM_K, qr, r32, hi);
    finishSM(pA0, pA1, alA, l_reg, pa0, pa1, pa2, pa3); SBAR();
    SLOAD(1, (j + 2) * 64); SBAR();
    pv_all<ND>(o, vb0, pa0, pa1, pa2, pa3); partialSM(pB0, pB1, m_reg, mnB, alB, C, thr);
    ATT_BAR(); SWAIT(); SWRITE(0, 0);
    RESC(alB); ATT_BAR();
    SBAR(); qkt<NQ, KROW>(pA0, pA1, K_lds, qr, r32, hi);
    finishSM(pB0, pB1, alB, l_reg, pa0, pa1, pa2, pa3); SBAR();
    if (j + 3 < NT) SLOAD(0, (j + 3) * 64); SBAR();
    pv_all<ND>(o, vb0 + SHM_V, pa0, pa1, pa2, pa3); partialSM(pA0, pA1, m_reg, mnA, alA, C, thr);
    ATT_BAR(); SWAIT(); SWRITE(1, 1);
    RESC(alA); ATT_BAR();
  }
  SBAR(); qkt<NQ, KROW>(pB0, pB1, K_lds + SHM_K, qr, r32, hi);
  finishSM(pA0, pA1, alA, l_reg, pa0, pa1, pa2, pa3); SBAR();
  pv_all<ND>(o, vb0, pa0, pa1, pa2, pa3); partialSM(pB0, pB1, m_reg, mnB, alB, C, thr);
  ATT_BAR(); RESC(alB);
  finishSM(pB0, pB1, alB, l_reg, pa0, pa1, pa2, pa3); SBAR();
  pv_all<ND>(o, vb0 + SHM_V, pa0, pa1, pa2, pa3);
  if (hi == 0) li_l[r32] = l_reg; asm volatile("s_waitcnt lgkmcnt(0)" ::: "memory");
#pragma unroll
  for (int r = 0; r < 16; ++r) rli[r] = __builtin_amdgcn_rcpf(li_l[crow(r, hi)]);
  ATT_BAR();
#undef SLOAD
#undef SWRITE
#undef SWAIT
#undef RESC
#undef ATT_BAR
}
}

typedef unsigned short bf16;
typedef float f32x4 __attribute__((ext_vector_type(4)));
typedef unsigned v4u __attribute__((ext_vector_type(4)));
constexpr int T = 32768, DM = 1024, SEQ = 2048, NBATCH = 16, DEPTH = 4, MEMLEN = 256, NIN = 7328, DFF = 4096;
constexpr int NWAVES = 8, NTHREADS = 512;
constexpr float ALPHA = 1.6817928305074290f;
constexpr int LDS_BYTES = 139264;
static_assert(att::ATT_LDS_END <= LDS_BYTES && pg8::STAGE_BYTES <= LDS_BYTES, "LDS map");
constexpr size_t MiB = 1u << 20;
constexpr size_t WS_BAR = 512 * 1024;
constexpr size_t WS_RSQ = 0, WS_RSKV = 256 * 1024;
constexpr size_t WS_COSM = 1 * MiB, WS_SINM = 3 * MiB, WS_COSD = 5 * MiB, WS_SIND = 6 * MiB;
constexpr size_t WS_W = 8 * MiB;
constexpr size_t WS_MEMB = 48 * MiB, WS_MEMKV = 56 * MiB, WS_XB = 64 * MiB;
constexpr size_t WS_DQ = 128 * MiB, WS_MQ = 192 * MiB, WS_QM = 224 * MiB, WS_LAT = 272 * MiB, WS_DK = 320 * MiB, WS_DV = 384 * MiB, WS_KVM = 448 * MiB, WS_END = 512 * MiB;
constexpr size_t WS_G = 272 * MiB, WS_MG = 336 * MiB;
constexpr size_t WS_HID = 128 * MiB;
constexpr size_t WO_IN = 0, WO_G = WO_IN + (size_t)4352 * 1024, WO_UQ = WO_G + (size_t)3072 * 1024, WO_UKV = WO_UQ + (size_t)768 * 384, WO_MKV = WO_UKV + (size_t)1024 * 256,
                 WO_BM = WO_MKV + (size_t)1024 * 1024, WO_BD = WO_BM + (size_t)1024 * 512, WO_BE = WO_BD + (size_t)1024 * 1024, WO_OUT = WO_BE + (size_t)1024 * 512,
                 WO_1 = WO_OUT + (size_t)1024 * 1024, WO_2 = WO_1 + (size_t)4096 * 1024, WO_END = WO_2 + (size_t)4096 * 1024;
static_assert(WO_END * 2 <= 40 * MiB, "weight copies fit");

struct Params {
    const float *x, *mem; const int* pos;
    const float *w_in, *b_gate, *q_norm, *kv_norm, *w_uq, *w_ukv, *dlam, *subln, *w_mkv, *w_br, *w_out, *ln1g, *ln1b, *w1, *w2, *ln2g, *ln2b;
    float* out; unsigned char* ws;
};
typedef const __attribute__((address_space(4))) Params* kparams_t;
__device__ __forceinline__ kparams_t getp() { kparams_t kp = (kparams_t)__builtin_amdgcn_kernarg_segment_ptr(); asm volatile("" : "+s"(kp)); return kp; }

#define LDS_WAIT() asm volatile("s_waitcnt lgkmcnt(0)" ::: "memory")
__device__ __forceinline__ unsigned f2bf_u(float f) { unsigned u = __builtin_bit_cast(unsigned, f); return (u + 0x7fffu + ((u >> 16) & 1u)) >> 16; }
__device__ __forceinline__ unsigned pk2(float lo, float hi) { return f2bf_u(lo) | (f2bf_u(hi) << 16); }
__device__ __forceinline__ float wave_sum(float v) {
#pragma unroll
    for (int o = 1; o < 64; o <<= 1) v += __shfl_xor(v, o);
    return v;
}

__device__ __forceinline__ void tr_item(const float* W, int ldw, int sc, int K, bf16* WT, int n0, int k0, const float* gain, LAS float* scr, int lane) {
    float vv[32];
#pragma unroll
    for (int i = 0; i < 32; ++i) { const int kk = 2 * i + (lane >> 5); vv[i] = (sc >= 0) ? W[(size_t)(k0 + kk) * ldw + sc + (lane & 31)] : 0.f; }
#pragma unroll
    for (int i = 0; i < 32; ++i) { const int kk = 2 * i + (lane >> 5); float v = vv[i]; if (sc >= 0 && gain) v *= gain[k0 + kk]; scr[kk * 33 + (lane & 31)] = v; }
    LDS_WAIT(); asm volatile("" ::: "memory");
    const int c = lane & 7;
#pragma unroll
    for (int j = 0; j < 4; ++j) { const int n = (lane >> 3) + 8 * j; const LAS float* s = scr + (8 * c) * 33 + n;
        v4u o; o.x = pk2(s[0 * 33], s[1 * 33]); o.y = pk2(s[2 * 33], s[3 * 33]); o.z = pk2(s[4 * 33], s[5 * 33]); o.w = pk2(s[6 * 33], s[7 * 33]);
        *(v4u*)(WT + (size_t)(n0 + n) * K + k0 + 8 * c) = o; }
    LDS_WAIT(); asm volatile("" ::: "memory");
}
__device__ __forceinline__ bool tr_job(int& it, const float* W, int ldw, int K, int N, bf16* WT, int kind, int coff, const float* gain, LAS float* scr, int lane) {
    const int nblk = N / 32, items = (K / 64) * nblk;
    if (it >= items) { it -= items; return false; }
    const int kb = it / nblk, nb = it % nblk, n0 = 32 * nb; int sc;
    if (kind == 0) sc = n0 + coff;
    else if (kind == 1) sc = (n0 < 672) ? n0 : (n0 < 768 ? -1 : n0 - 96);
    else sc = (n0 < 512) ? (n0 >> 6) * 96 + (n0 & 63) : ((n0 - 512) >> 5) * 96 + 64;
    tr_item(W, ldw, sc, K, WT, n0, 64 * kb, gain, scr, lane);
    return true;
}
__device__ __forceinline__ void convert_weights(int l, LAS unsigned char* lds, int gw, int NGW, int wave, int lane_) {
    int lane = lane_; asm volatile("" : "+v"(lane)); const kparams_t kp = getp();
    LAS float* scr = (LAS float*)(lds + wave * 16384);
    bf16* Wb = (bf16*)(kp->ws + WS_W);
    const float* w_in = kp->w_in + (size_t)l * DM * NIN; const float* wbr = kp->w_br + (size_t)l * 2048 * 1024;
    constexpr int NITEMS = 16 * 136 + 16 * 96 + 6 * 24 + 4 * 32 + 16 * 32 + 8 * 32 + 16 * 32 + 8 * 32 + 16 * 32 + 16 * 128 + 64 * 32;
    for (int item = gw; item < NITEMS; item += NGW) {
        int it = item;
        if (tr_job(it, w_in, NIN, 1024, 4352, Wb + WO_IN, 1, 0, nullptr, scr, lane)) continue;
        if (tr_job(it, w_in, NIN, 1024, 3072, Wb + WO_G, 0, 4256, nullptr, scr, lane)) continue;
        if (tr_job(it, kp->w_uq + (size_t)l * 384 * 768, 768, 384, 768, Wb + WO_UQ, 2, 0, kp->q_norm + l * 384, scr, lane)) continue;
        if (tr_job(it, kp->w_ukv + (size_t)l * 256 * 1024, 1024, 256, 1024, Wb + WO_UKV, 0, 0, kp->kv_norm + l * 256, scr, lane)) continue;
        if (tr_job(it, kp->w_mkv + (size_t)l * 1024 * 1024, 1024, 1024, 1024, Wb + WO_MKV, 0, 0, nullptr, scr, lane)) continue;
        if (tr_job(it, wbr, 1024, 512, 1024, Wb + WO_BM, 0, 0, nullptr, scr, lane)) continue;
        if (tr_job(it, wbr + (size_t)512 * 1024, 1024, 1024, 1024, Wb + WO_BD, 0, 0, nullptr, scr, lane)) continue;
        if (tr_job(it, wbr + (size_t)1536 * 1024, 1024, 512, 1024, Wb + WO_BE, 0, 0, nullptr, scr, lane)) continue;
        if (tr_job(it, kp->w_out + (size_t)l * 1024 * 1024, 1024, 1024, 1024, Wb + WO_OUT, 0, 0, nullptr, scr, lane)) continue;
        if (tr_job(it, kp->w1 + (size_t)l * 1024 * 4096, 4096, 1024, 4096, Wb + WO_1, 0, 0, nullptr, scr, lane)) continue;
        tr_job(it, kp->w2 + (size_t)l * 4096 * 1024, 1024, 4096, 1024, Wb + WO_2, 0, 0, nullptr, scr, lane);
    }
}
__device__ __forceinline__ void ln_rows(float* X, bf16* XB, const float* g, const float* b, int gw, int NGW, int lane_, int row_end = T) {
    int lane = lane_; asm volatile("" : "+v"(lane));
    f32x4 gv[4], bv[4];
#pragma unroll
    for (int j = 0; j < 4; ++j) { gv[j] = ((const f32x4*)g)[lane + 64 * j]; bv[j] = ((const f32x4*)b)[lane + 64 * j]; }
    for (int m = gw; m < row_end; m += 2 * NGW) {
        const int m2 = (m + NGW < row_end) ? m + NGW : m;
        f32x4* xr = (f32x4*)(X + (size_t)m * DM) + lane; f32x4* xr2 = (f32x4*)(X + (size_t)m2 * DM) + lane; f32x4 v[4], w[4]; float s = 0.f, t = 0.f;
#pragma unroll
        for (int j = 0; j < 4; ++j) { v[j] = xr[64 * j]; w[j] = xr2[64 * j]; }
#pragma unroll
        for (int j = 0; j < 4; ++j) { s += (v[j].x + v[j].y) + (v[j].z + v[j].w); t += (w[j].x + w[j].y) + (w[j].z + w[j].w); }
        const float mean = wave_sum(s) * (1.f / DM), mean2 = wave_sum(t) * (1.f / DM); float s2 = 0.f, t2 = 0.f;
#pragma unroll
        for (int j = 0; j < 4; ++j) { v[j] = v[j] - mean; s2 += (v[j].x * v[j].x + v[j].y * v[j].y) + (v[j].z * v[j].z + v[j].w * v[j].w);
                                      w[j] = w[j] - mean2; t2 += (w[j].x * w[j].x + w[j].y * w[j].y) + (w[j].z * w[j].z + w[j].w * w[j].w); }
        const float rstd = 1.f / sqrtf(wave_sum(s2) * (1.f / DM) + 1e-5f), rstd2 = 1.f / sqrtf(wave_sum(t2) * (1.f / DM) + 1e-5f);
        unsigned long long* o8 = (unsigned long long*)(XB + (size_t)m * DM) + lane; unsigned long long* o82 = (unsigned long long*)(XB + (size_t)m2 * DM) + lane;
#pragma unroll
        for (int j = 0; j < 4; ++j) { const f32x4 y = v[j] * rstd * gv[j] + bv[j]; xr[64 * j] = y;
            o8[64 * j] = (unsigned long long)pk2(y.x, y.y) | ((unsigned long long)pk2(y.z, y.w) << 32); }
        if (m2 != m) {
#pragma unroll
        for (int j = 0; j < 4; ++j) { const f32x4 y = w[j] * rstd2 * gv[j] + bv[j]; xr2[64 * j] = y;
            o82[64 * j] = (unsigned long long)pk2(y.x, y.y) | ((unsigned long long)pk2(y.z, y.w) << 32); } }
    }
}
__device__ __forceinline__ void rowscale_rows(const bf16* lat, float* rsq, float* rskv, int gw, int NGW, int lane_) {
    int lane = lane_; asm volatile("" : "+v"(lane));
    for (int row = gw; row < T; row += 4 * NGW) {
        unsigned w[4][5];
#pragma unroll
        for (int q = 0; q < 4; ++q) { const int rq = (row + q * NGW < T) ? row + q * NGW : row; const unsigned* src = (const unsigned*)(lat + (size_t)rq * 768) + lane;
#pragma unroll
            for (int k = 0; k < 5; ++k) w[q][k] = src[64 * k]; }
#pragma unroll
        for (int q = 0; q < 4; ++q) { float sq = 0.f, sk = 0.f;
#pragma unroll
            for (int k = 0; k < 5; ++k) { const float a = __uint_as_float(w[q][k] << 16), b = __uint_as_float(w[q][k] & 0xffff0000u); if (k < 3) sq += a * a + b * b; else sk += a * a + b * b; }
            sq = wave_sum(sq); sk = wave_sum(sk);
            if (lane == 0 && row + q * NGW < T) { rsq[row + q * NGW] = 1.0f / sqrtf(sq * (1.f / 384.f) + 1e-6f); rskv[row + q * NGW] = 1.0f / sqrtf(sk * (1.f / 256.f) + 1e-6f); } }
    }
}

#ifndef PH_MASK
#define PH_MASK 0xffff
#endif

#define WSP(T_, off) ((T_*)(ws + (off)))
#define XB_TMO      128
#define XB_XCNT(j)  (256  + 64 * (j))
#define XB_XSUB(j)  (1280 + 64 * (j))
#define XB_XGEN(j)  (2304 + 64 * (j))
#define XB_TOP      3328
#define XB_TOPGEN   3392
#define XCD_BAR_WORDS 3456
#define XB_SPIN_CAP (1u << 18)

__device__ __forceinline__ unsigned xb_ld(unsigned* p)              { return __hip_atomic_load(p, __ATOMIC_RELAXED, __HIP_MEMORY_SCOPE_AGENT); }
__device__ __forceinline__ unsigned xb_add(unsigned* p, unsigned v) { return __hip_atomic_fetch_add(p, v, __ATOMIC_RELAXED, __HIP_MEMORY_SCOPE_AGENT); }
__device__ __forceinline__ unsigned xb_xcc_id() { return (unsigned)__builtin_amdgcn_s_getreg((3 << 11) | 20) & 0xFu; }
#define XB_SPIN(cond, bar) do { unsigned _sp = 0; while (cond) { __builtin_amdgcn_s_sleep(1); \
    if ((++_sp & 255u) == 0u) { if (xb_ld(&(bar)[XB_TMO])) break; if (_sp > XB_SPIN_CAP) { atomicAdd(&(bar)[XB_TMO], 1u); break; } } } } while (0)

struct XcdBarrier {
    unsigned* bar; unsigned x;
    volatile LAS unsigned* st;
};

__device__ __forceinline__ XcdBarrier xcd_barrier_post(unsigned* bar, volatile LAS unsigned* st) {
    XcdBarrier b; b.bar = bar; b.x = xb_xcc_id(); b.st = st;
    if (threadIdx.x == 0) (void)xb_add(&bar[XB_XCNT(b.x)], 1u);
    return b;
}
__device__ __forceinline__ void xcd_barrier_complete(unsigned* bar, unsigned x, unsigned& nloc, unsigned& nx) {
    const unsigned G = gridDim.x * gridDim.y * gridDim.z;
    unsigned sum, cnt, mine, sp = 0u;
    for (;;) {
        sum = 0u; cnt = 0u; mine = 0u;
#pragma unroll
        for (unsigned j = 0; j < 16; ++j) { const unsigned c = xb_ld(&bar[XB_XCNT(j)]); sum += c; cnt += (c > 0u) ? 1u : 0u; mine = (j == x) ? c : mine; }
        if (sum == G) break;
        __builtin_amdgcn_s_sleep(1);
        if ((++sp & 255u) == 0u) { if (xb_ld(&bar[XB_TMO])) break; if (sp > XB_SPIN_CAP) { atomicAdd(&bar[XB_TMO], 1u); break; } }
    }
    nloc = mine > 0u ? mine : 1u; nx = cnt > 0u ? cnt : 1u;
}

__device__ __forceinline__ void xcd_barrier(const XcdBarrier& b) {
    asm volatile("s_waitcnt vmcnt(0)" ::: "memory");
    __syncthreads();
    if (threadIdx.x == 0) {
        unsigned* bar = b.bar;
        __builtin_amdgcn_s_waitcnt(0);
        unsigned nloc = b.st[0], nx = b.st[1];
        if (nloc == 0u) { xcd_barrier_complete(bar, b.x, nloc, nx); b.st[0] = nloc; b.st[1] = nx; }
        const unsigned old = xb_add(&bar[XB_XSUB(b.x)], 1u);
        const unsigned gen = old / nloc;
        if (old + 1u == (gen + 1u) * nloc) {
            __builtin_amdgcn_fence(__ATOMIC_RELEASE, "agent");
            asm volatile("s_waitcnt vmcnt(0)" ::: "memory");
            const unsigned og = xb_add(&bar[XB_TOP], 1u);
            const unsigned tg = og / nx;
            if (og + 1u == (tg + 1u) * nx) xb_add(&bar[XB_TOPGEN], 1u);
            else XB_SPIN(xb_ld(&bar[XB_TOPGEN]) == tg, bar);
            __builtin_amdgcn_fence(__ATOMIC_ACQUIRE, "agent");
            xb_add(&bar[XB_XGEN(b.x)], 1u);
            asm volatile("s_waitcnt vmcnt(0)" ::: "memory");
        } else {
            XB_SPIN(xb_ld(&bar[XB_XGEN(b.x)]) == gen, bar);
            __builtin_amdgcn_fence(__ATOMIC_ACQUIRE, "agent");
            asm volatile("s_waitcnt vmcnt(0)" ::: "memory");
        }
    }
    __syncthreads();
}

#define GRID_SYNC() do { XcdBarrier xb_; xb_.bar = (unsigned*)(getp()->ws + WS_BAR); xb_.x = xb_xcc_id(); xb_.st = (volatile LAS unsigned*)(lds + LDS_BYTES - 64); xcd_barrier(xb_); } while (0)
__global__ void __launch_bounds__(NTHREADS, 2) fwd_megakernel(Params p_unused) {
    extern __shared__ __attribute__((aligned(16))) unsigned char lds_raw[];
    cg::grid_group grid = cg::this_grid();
    LAS unsigned char* lds = (LAS unsigned char*)lds_raw;
    const int tid = threadIdx.x, lane = tid & 63, wave = __builtin_amdgcn_readfirstlane(tid >> 6);
    const int G = gridDim.x, bx = blockIdx.x;
    const int vcu = (G % 8 == 0) ? (bx % 8) * (G / 8) + bx / 8 : bx;
    const int gw = vcu * NWAVES + wave, NGW = G * NWAVES;
    volatile LAS unsigned* xst = (volatile LAS unsigned*)(lds + LDS_BYTES - 64);
    if (tid < 2) xst[tid] = 0u;
    __syncthreads();
    (void)xcd_barrier_post((unsigned*)(getp()->ws + WS_BAR), xst);
    grid.sync();

#if (PH_MASK & 1)
    {   const kparams_t kp = getp(); unsigned char* ws = kp->ws; float* X = kp->out; const float* xin = kp->x; const float* memin = kp->mem; const int* pos = kp->pos;
        bf16 *XB = WSP(bf16, WS_XB), *MEMB = WSP(bf16, WS_MEMB);
        float *COSM = WSP(float, WS_COSM), *SINM = WSP(float, WS_SINM), *COSD = WSP(float, WS_COSD), *SIND = WSP(float, WS_SIND);
        const long gt = (long)bx * NTHREADS + tid, NGT = (long)G * NTHREADS;
        for (long i = gt; i < (long)T * DM / 4; i += 4 * NGT) { f32x4 v[4];
#pragma unroll
            for (int q = 0; q < 4; ++q) v[q] = (i + q * NGT < (long)T * DM / 4) ? ((const f32x4*)xin)[i + q * NGT] : (f32x4){0.f, 0.f, 0.f, 0.f};
#pragma unroll
            for (int q = 0; q < 4; ++q) if (i + q * NGT < (long)T * DM / 4) { ((f32x4*)X)[i + q * NGT] = v[q];
                ((unsigned long long*)XB)[i + q * NGT] = (unsigned long long)pk2(v[q].x, v[q].y) | ((unsigned long long)pk2(v[q].z, v[q].w) << 32); } }
        for (long i = gt; i < (long)NBATCH * MEMLEN * DM / 4; i += NGT) { const f32x4 v = ((const f32x4*)memin)[i];
            ((unsigned long long*)MEMB)[i] = (unsigned long long)pk2(v.x, v.y) | ((unsigned long long)pk2(v.z, v.w) << 32); }
        for (long i = gt; i < (long)T * 16; i += NGT) { const int t = (int)(i >> 4), j = (int)(i & 15); const float inv = exp2f(-(float)(2 * j) * (18.931568569324174f / 32.f)); const float ang = (float)pos[t] * inv;
            const double a = (double)ang, n = rint(a * 0.15915494309189535), r = a - n * 6.283185307179586;
            COSM[i] = (float)cos(r); SINM[i] = (float)sin(r); }
        for (long i = gt; i < (long)T * 8; i += NGT) { const int t = (int)(i >> 3), j = (int)(i & 7); const float inv = exp2f(-(float)(2 * j) * (18.931568569324174f / 16.f)); const float ang = (float)pos[t] * inv;
            const double a = (double)ang, n = rint(a * 0.15915494309189535), r = a - n * 6.283185307179586;
            COSD[i] = (float)cos(r); SIND[i] = (float)sin(r); }
        convert_weights(0, lds, gw, NGW, wave, lane);
    }
    GRID_SYNC();
#endif

    for (int l = 0; l < DEPTH; ++l) {
        const float lambda_init = 0.8f - 0.6f * __expf(-0.3f * (float)l);
#if (PH_MASK & 2)
        {   const kparams_t kp = getp(); unsigned char* ws = kp->ws; bf16* Wb = WSP(bf16, WS_W);
            {   pg8::Gemm g{WSP(bf16, WS_XB), Wb + WO_IN, T, 4352, 1024, 1024, 1024}; pg8::StaticOrder S; S.init(T, 4352, G, bx);
                pg8::EpiH E{WSP(bf16, WS_LAT), WSP(bf16, WS_DQ), WSP(bf16, WS_DK), WSP(bf16, WS_DV), WSP(bf16, WS_MQ), WSP(float, WS_COSD), WSP(float, WS_SIND), WSP(float, WS_COSM), WSP(float, WS_SINM)};
                pg8::gemm_phase<pg8::EpiH, pg8::StaticOrder, true, true>(lds, g, S, E); }
            {   pg8::Gemm g{WSP(bf16, WS_MEMB), Wb + WO_MKV, NBATCH * MEMLEN, 1024, 1024, 1024, 1024}; pg8::StaticOrder S; S.init(NBATCH * MEMLEN, 1024, G, (bx + G / 2) % G);
                pg8::EpiScale<false> E{WSP(bf16, WS_MEMKV), 1024, nullptr, nullptr, nullptr};
                pg8::gemm_phase<pg8::EpiScale<false>, pg8::StaticOrder, true, true>(lds, g, S, E); } }
        GRID_SYNC();
#endif
#if (PH_MASK & 4)
        {   const kparams_t kp = getp(); unsigned char* ws = kp->ws; bf16* Wb = WSP(bf16, WS_W); bf16* LAT = WSP(bf16, WS_LAT); float *RSQ = WSP(float, WS_RSQ), *RSKV = WSP(float, WS_RSKV);
            rowscale_rows(LAT, RSQ, RSKV, gw, NGW, lane);
            GRID_SYNC();
            pg8::StaticOrder Sq; Sq.init(T, 768, G, bx); pg8::StaticOrder Skv; Skv.init(T, 1024, G, bx);
            {   pg8::Gemm g{LAT, Wb + WO_UQ, T, 768, 384, 768, 384}; pg8::EpiScale<true> E{WSP(bf16, WS_QM), 768, RSQ, WSP(float, WS_COSM), WSP(float, WS_SINM)};
                pg8::gemm_phase<pg8::EpiScale<true>, pg8::StaticOrder, true, true>(lds, g, Sq, E); }
            {   pg8::Gemm g{LAT + 384, Wb + WO_UKV, T, 1024, 256, 768, 256}; pg8::EpiScale<false> E{WSP(bf16, WS_KVM), 1024, RSKV, nullptr, nullptr};
                pg8::gemm_phase<pg8::EpiScale<false>, pg8::StaticOrder, true, true>(lds, g, Skv, E); } }
        GRID_SYNC();
#endif
        {
            const att::lptr alds = (att::lptr)lds;
            { const int rep = 1;
            int lane_a = lane; asm volatile("" : "+v"(lane_a)); const int r32 = lane_a & 31, hi = lane_a >> 5;
#if (PH_MASK & 8)
            {   const kparams_t kp = getp(); unsigned char* ws = kp->ws; bf16 *DQ = WSP(bf16, WS_DQ), *DK = WSP(bf16, WS_DK), *DV = WSP(bf16, WS_DV);
                float lam;
                {   const float* dl = kp->dlam + (size_t)l * 256; const float a = wave_sum(dl[lane_a] * dl[64 + lane_a]), b2 = wave_sum(dl[128 + lane_a] * dl[192 + lane_a]);
                    lam = __expf(a) - __expf(b2) + lambda_init; }
                const float* subln = kp->subln + l * 128;
                for (int idx = vcu; idx < NBATCH * 8 * 8; idx += G) {
                    const int bh = idx >> 3, qb = idx & 7, b = bh >> 3, h = bh & 7; const size_t row0 = (size_t)b * SEQ + qb * 256, key0 = (size_t)b * SEQ;
                    att::f32x16 o[4]; float rli[16];
                    att::Args A; A.ldq = 1024; A.ldk0 = 1024; A.ldk1 = 0; A.ldv = 1024; A.nkeys = SEQ; A.C = 0.125f * 1.4426950408889634f; A.thr = 8.f / 0.125f; A.Q1 = nullptr; A.K1 = nullptr;
                    A.Q0 = DQ + row0 * 1024 + h * 128; A.K0 = DK + key0 * 1024 + h * 128; A.V = DV + key0 * 1024 + h * 128;
                    att::attn_core<1>(A, alds, o, rli);
                    int ls = lane_a; asm volatile("" : "+v"(ls)); LAS unsigned* stash = (LAS unsigned*)(lds + att::STASH_OFF) + wave * 2048 + ls;
#pragma unroll
                    for (int d = 0; d < 4; ++d)
#pragma unroll
                        for (int j = 0; j < 8; ++j) stash[(d * 8 + j) * 64] = att::cvtpk(o[d][2 * j] * rli[2 * j], o[d][2 * j + 1] * rli[2 * j + 1]);
                    A.Q0 += 64; A.K0 += 64;
                    att::attn_core<1>(A, alds, o, rli);
                    float ss[16];
#pragma unroll
                    for (int r = 0; r < 16; ++r) ss[r] = 0.f;
#pragma unroll
                    for (int d = 0; d < 4; ++d)
#pragma unroll
                        for (int j = 0; j < 8; ++j) { const unsigned w = stash[(d * 8 + j) * 64];
                            const float d0v = __uint_as_float(w << 16) - lam * (o[d][2 * j] * rli[2 * j]), d1v = __uint_as_float(w & 0xffff0000u) - lam * (o[d][2 * j + 1] * rli[2 * j + 1]);
                            o[d][2 * j] = d0v; o[d][2 * j + 1] = d1v; ss[2 * j] += d0v * d0v; ss[2 * j + 1] += d1v * d1v; }
#pragma unroll
                    for (int r = 0; r < 16; ++r) { float s = ss[r]; s += __shfl_xor(s, 1); s += __shfl_xor(s, 2); s += __shfl_xor(s, 4); s += __shfl_xor(s, 8); s += __shfl_xor(s, 16);
                        ss[r] = (1.0f / sqrtf(s * (1.f / 128.f) + 1e-5f)) * (1.f - lambda_init); }
                    int lq = lane_a; asm volatile("" : "+v"(lq));
                    bf16* Ob = DQ + (row0 + wave * 32 + 4 * (lq >> 5)) * 1024 + h * 128 + (lq & 31);
#pragma unroll
                    for (int d = 0; d < 4; ++d) { const float gsub = subln[d * 32 + (lq & 31)];
#pragma unroll
                        for (int r = 0; r < 16; ++r) if (rep) Ob[att::crow(r, 0) * 1024 + d * 32] = att::f2bf(o[d][r] * ss[r] * gsub); }
                } }
#endif
#if (PH_MASK & 16)
            {   const kparams_t kp = getp(); unsigned char* ws = kp->ws; bf16 *QM = WSP(bf16, WS_QM), *KVM = WSP(bf16, WS_KVM), *LAT = WSP(bf16, WS_LAT);
                for (int idx = vcu; idx < NBATCH * 8 * 8; idx += G) {
                    const int bh = idx >> 3, qb = idx & 7, b = bh >> 3, h = bh & 7; const size_t row0 = (size_t)b * SEQ + qb * 256, key0 = (size_t)b * SEQ;
                    att::f32x16 o[2]; float rli[16];
                    att::Args A; A.ldq = 768; A.ldk0 = 1024; A.ldk1 = 768; A.ldv = 1024; A.nkeys = SEQ; A.C = 0.10206207261596575f * 1.4426950408889634f; A.thr = 8.f / 0.10206207261596575f;
                    A.Q0 = QM + row0 * 768 + h * 64; A.Q1 = QM + row0 * 768 + 512 + h * 32; A.K0 = KVM + key0 * 1024 + h * 128; A.K1 = LAT + key0 * 768 + 640; A.V = KVM + key0 * 1024 + h * 128 + 64;
                    att::attn_core<0>(A, alds, o, rli);
                    int lq = lane_a; asm volatile("" : "+v"(lq));
                    bf16* Ob = QM + (row0 + wave * 32 + 4 * (lq >> 5)) * 768 + h * 64 + (lq & 31);
#pragma unroll
                    for (int d = 0; d < 2; ++d)
#pragma unroll
                        for (int r = 0; r < 16; ++r) if (rep) Ob[att::crow(r, 0) * 768 + d * 32] = att::f2bf(o[d][r] * rli[r]);
                } }
#endif
#if (PH_MASK & 32)
            {   const kparams_t kp = getp(); unsigned char* ws = kp->ws; bf16 *MQ = WSP(bf16, WS_MQ), *MEMKV = WSP(bf16, WS_MEMKV);
                for (int idx = vcu; idx < NBATCH * 4 * 8; idx += G) {
                    const int bh = idx >> 3, qb = idx & 7, b = bh >> 2, h = bh & 3; const size_t row0 = (size_t)b * SEQ + qb * 256, key0 = (size_t)b * MEMLEN;
                    att::f32x16 o[4]; float rli[16];
                    att::Args A; A.ldq = 512; A.ldk0 = 1024; A.ldk1 = 0; A.ldv = 1024; A.nkeys = MEMLEN; A.C = 0.08838834764831845f * 1.4426950408889634f; A.thr = 8.f / 0.08838834764831845f; A.Q1 = nullptr; A.K1 = nullptr;
                    A.Q0 = MQ + row0 * 512 + h * 128; A.K0 = MEMKV + key0 * 1024 + h * 128; A.V = MEMKV + key0 * 1024 + 512 + h * 128;
                    att::attn_core<2>(A, alds, o, rli);
                    int lq = lane_a; asm volatile("" : "+v"(lq));
                    bf16* Ob = MQ + (row0 + wave * 32 + 4 * (lq >> 5)) * 512 + h * 128 + (lq & 31);
#pragma unroll
                    for (int d = 0; d < 4; ++d)
#pragma unroll
                        for (int r = 0; r < 16; ++r) if (rep) Ob[att::crow(r, 0) * 512 + d * 32] = att::f2bf(o[d][r] * rli[r]);
                } }
#endif
            }
        }
        GRID_SYNC();
#if (PH_MASK & 64)
        {   const kparams_t kp = getp(); unsigned char* ws = kp->ws; bf16* Wb = WSP(bf16, WS_W); bf16 *XB = WSP(bf16, WS_XB), *GB = WSP(bf16, WS_G), *MG = WSP(bf16, WS_MG);
            pg8::StaticOrder S; S.init(T, 1024, G, bx); const float* bg = kp->b_gate + (size_t)l * 3 * 1024;
            {
            {   pg8::Gemm g{XB, Wb + WO_G, T, 1024, 1024, 1024, 1024}; pg8::EpiGate E{GB, bg};
                pg8::gemm_phase<pg8::EpiGate, pg8::StaticOrder, true, true>(lds, g, S, E); }
            {   pg8::Gemm g{WSP(bf16, WS_QM), Wb + WO_BM, T, 1024, 512, 768, 512}; pg8::EpiBranch<true> E{GB, MG};
                pg8::gemm_phase<pg8::EpiBranch<true>, pg8::StaticOrder, true, true>(lds, g, S, E); }
            {   pg8::Gemm g{XB, Wb + WO_G + (size_t)1024 * 1024, T, 1024, 1024, 1024, 1024}; pg8::EpiGate E{GB, bg + 1024};
                pg8::gemm_phase<pg8::EpiGate, pg8::StaticOrder, true, true>(lds, g, S, E); }
            {   pg8::Gemm g{WSP(bf16, WS_DQ), Wb + WO_BD, T, 1024, 1024, 1024, 1024}; pg8::EpiBranch<false> E{GB, MG};
                pg8::gemm_phase<pg8::EpiBranch<false>, pg8::StaticOrder, true, true>(lds, g, S, E); }
            {   pg8::Gemm g{XB, Wb + WO_G + (size_t)2048 * 1024, T, 1024, 1024, 1024, 1024}; pg8::EpiGate E{GB, bg + 2048};
                pg8::gemm_phase<pg8::EpiGate, pg8::StaticOrder, true, true>(lds, g, S, E); }
            {   pg8::Gemm g{WSP(bf16, WS_MQ), Wb + WO_BE, T, 1024, 512, 512, 512}; pg8::EpiBranch<false> E{GB, MG};
                pg8::gemm_phase<pg8::EpiBranch<false>, pg8::StaticOrder, true, true>(lds, g, S, E); } } }
        GRID_SYNC();
#endif
#if (PH_MASK & 128)
        {   const kparams_t kp = getp(); unsigned char* ws = kp->ws;
            pg8::Gemm g{WSP(bf16, WS_MG), WSP(bf16, WS_W) + WO_OUT, T, 1024, 1024, 1024, 1024}; pg8::StaticOrder S; S.init(T, 1024, G, bx); pg8::EpiRes E{kp->out, ALPHA};
            pg8::gemm_phase<pg8::EpiRes, pg8::StaticOrder, true, true>(lds, g, S, E); }
        GRID_SYNC();
#endif
        {   const kparams_t kp = getp(); unsigned char* ws = kp->ws;
            ln_rows(kp->out, WSP(bf16, WS_XB), kp->ln1g + l * DM, kp->ln1b + l * DM, gw, NGW, lane); }
        GRID_SYNC();
#if (PH_MASK & 256)
        {   const kparams_t kp = getp(); unsigned char* ws = kp->ws;
            pg8::Gemm g{WSP(bf16, WS_XB), WSP(bf16, WS_W) + WO_1, T, 4096, 1024, 1024, 1024}; pg8::StaticOrder S; S.init(T, 4096, G, bx); pg8::EpiRelu2 E{WSP(bf16, WS_HID), 4096};
            pg8::gemm_phase<pg8::EpiRelu2, pg8::StaticOrder, true, true>(lds, g, S, E); }
        GRID_SYNC();
#endif
#if (PH_MASK & 512)
        {   const kparams_t kp = getp(); unsigned char* ws = kp->ws;
            pg8::Gemm g{WSP(bf16, WS_HID), WSP(bf16, WS_W) + WO_2, T, 1024, 4096, 4096, 4096}; pg8::StaticOrder S; S.init(T, 1024, G, bx); pg8::EpiRes E{kp->out, ALPHA};
            pg8::gemm_phase<pg8::EpiRes, pg8::StaticOrder, true, true>(lds, g, S, E); }
        GRID_SYNC();
#endif
        {   const kparams_t kp = getp(); unsigned char* ws = kp->ws;
            ln_rows(kp->out, WSP(bf16, WS_XB), kp->ln2g + l * DM, kp->ln2b + l * DM, gw, NGW, lane); }
        if (l + 1 < DEPTH) { convert_weights(l + 1, lds, gw, NGW, wave, lane); GRID_SYNC(); }
    }
}

extern "C" void kernel_launch(void* const* d_in, const int* in_sizes, int n_in, void* d_out, int out_size, void* d_ws, size_t ws_size, hipStream_t stream) {
    static int grid = 0;
    if (grid == 0) {
        if (n_in != 20 || in_sizes[0] != T * DM || out_size != T * DM || ws_size < WS_END) {
            fprintf(stderr, "kernel_launch: unexpected shapes (n_in %d, in0 %d, out %d, ws %zu; need ws >= %zu); nothing launched\n", n_in, n_in > 0 ? in_sizes[0] : -1, out_size, ws_size, (size_t)WS_END); grid = -1; return; }
        int dev = 0, cus = 0, per_cu = 0;
        if (hipGetDevice(&dev) != hipSuccess || hipDeviceGetAttribute(&cus, hipDeviceAttributeMultiprocessorCount, dev) != hipSuccess) { grid = -1; return; }
        if (hipFuncSetAttribute((const void*)fwd_megakernel, hipFuncAttributeMaxDynamicSharedMemorySize, LDS_BYTES) != hipSuccess) { fprintf(stderr, "kernel_launch: hipFuncSetAttribute failed\n"); grid = -1; return; }
        if (hipOccupancyMaxActiveBlocksPerMultiprocessor(&per_cu, (const void*)fwd_megakernel, NTHREADS, LDS_BYTES) != hipSuccess || per_cu < 1) { fprintf(stderr, "kernel_launch: occupancy query says %d\n", per_cu); per_cu = 1; }
        (void)hipGetLastError();
        grid = cus * 1;
    }
    if (grid < 0) return;
    if (hipMemsetAsync((char*)d_ws + WS_BAR, 0, 16384, stream) != hipSuccess) { fprintf(stderr, "kernel_launch: hipMemsetAsync failed\n"); return; }
    Params p{};
    p.x = (const float*)d_in[0]; p.mem = (const float*)d_in[1]; p.pos = (const int*)d_in[2];
    p.w_in = (const float*)d_in[3]; p.b_gate = (const float*)d_in[4]; p.q_norm = (const float*)d_in[5]; p.kv_norm = (const float*)d_in[6];
    p.w_uq = (const float*)d_in[7]; p.w_ukv = (const float*)d_in[8]; p.dlam = (const float*)d_in[9]; p.subln = (const float*)d_in[10];
    p.w_mkv = (const float*)d_in[11]; p.w_br = (const float*)d_in[12]; p.w_out = (const float*)d_in[13]; p.ln1g = (const float*)d_in[14]; p.ln1b = (const float*)d_in[15];
    p.w1 = (const float*)d_in[16]; p.w2 = (const float*)d_in[17]; p.ln2g = (const float*)d_in[18]; p.ln2b = (const float*)d_in[19];
    p.out = (float*)d_out; p.ws = (unsigned char*)d_ws;
    void* args[] = {&p};
    hipError_t e = hipLaunchCooperativeKernel((const void*)fwd_megakernel, dim3(grid), dim3(NTHREADS), args, LDS_BYTES, stream);
    if (e != hipSuccess) fprintf(stderr, "kernel_launch: cooperative launch failed: %s (grid %d)\n", hipGetErrorString(e), grid);
}
```

```cpp
#include <hip/hip_runtime.h>
#include <hip/hip_cooperative_groups.h>
#include <cstdio>
#include <cstdint>
#include <cmath>
namespace cg = cooperative_groups;

namespace pg8 {
#define PG8_LAS __attribute__((address_space(3)))
typedef unsigned short bf16_t;
typedef short bf16x8 __attribute__((ext_vector_type(8)));
typedef float f32x4 __attribute__((ext_vector_type(4)));
typedef unsigned u32x4 __attribute__((ext_vector_type(4)));
constexpr int BM = 256, BK = 64, HALF = 128, HTB = HALF * BK * 2  , STAGE_BYTES = 8 * HTB, NXCD = 8, WGM = 8;

__host__ __device__ __forceinline__ int lds_byte(int r, int c) { const int st = (r >> 4) * 2 + (c >> 5), rr = r & 15, cc = c & 31, ob = rr * 64 + cc * 2; return st * 1024 + (ob ^ (((ob >> 9) & 1) << 5)); }
__host__ __device__ __forceinline__ void stage_rc(int b, int& R, int& C) { const int st = b / 1024, sb = b % 1024, swz = sb ^ (((sb >> 9) & 1) << 5); R = (st >> 1) * 16 + swz / 64; C = (st & 1) * 32 + (swz % 64) / 2; }
__host__ __device__ __forceinline__ int perm32(int rho) { const int n = rho >> 4, i = rho & 15; return 8 * (i >> 2) + 4 * n + (i & 3); }

struct Unit { int pm, pn; };
struct Gemm { const bf16_t* A; const bf16_t* Bt; int M, N, K, lda, ldb; };

struct StaticOrder {
    int nM, nN, nwg, G, c;
    __host__ __device__ void init(int M, int N, int G_, int c_) { nM = M / BM; nN = N / BM; nwg = nM * nN; G = G_; c = c_; }
    __host__ __device__ bool next(int i, Unit& u) const {
        const long L = (long)i * G + c; if (L >= nwg) return false;
        int wgid = (int)L; { const int q = nwg / NXCD, r = nwg % NXCD, xcd = wgid % NXCD, off = wgid / NXCD; wgid = (xcd < r ? xcd * (q + 1) : r * (q + 1) + (xcd - r) * q) + off; }
        const int nig = WGM * nN, gid = wgid / nig, fm = gid * WGM, gsz = (nM - fm) < WGM ? (nM - fm) : WGM;
        u.pm = fm + ((wgid % nig) % gsz); u.pn = (wgid % nig) / gsz; return true;
    }
    __device__ __forceinline__ void a_ready(const Unit&) const {}
    __device__ __forceinline__ void done(const Unit&) const {}
};

__device__ __forceinline__ unsigned cvt_pk_bf16(float lo, float hi) { unsigned r; asm volatile("v_cvt_pk_bf16_f32 %0, %1, %2" : "=v"(r) : "v"(lo), "v"(hi)); return r; }
__device__ __forceinline__ u32x4 pack8(const f32x4 v0, const f32x4 v1) { u32x4 w; w.x = cvt_pk_bf16(v0[0], v0[1]); w.y = cvt_pk_bf16(v0[2], v0[3]); w.z = cvt_pk_bf16(v1[0], v1[1]); w.w = cvt_pk_bf16(v1[2], v1[3]); return w; }
__device__ __forceinline__ u32x4 ld16_l2(const bf16_t* p) { const unsigned long long* q = (const unsigned long long*)p; const unsigned long long a = __hip_atomic_load(q, __ATOMIC_RELAXED, __HIP_MEMORY_SCOPE_AGENT), b = __hip_atomic_load(q + 1, __ATOMIC_RELAXED, __HIP_MEMORY_SCOPE_AGENT);
    u32x4 r; r.x = (unsigned)a; r.y = (unsigned)(a >> 32); r.z = (unsigned)b; r.w = (unsigned)(b >> 32); return r; }
__device__ __forceinline__ void st16(void* p, const u32x4 w) { unsigned long long* q = (unsigned long long*)p;
    __hip_atomic_store(q, (unsigned long long)w.x | ((unsigned long long)w.y << 32), __ATOMIC_RELAXED, __HIP_MEMORY_SCOPE_SYSTEM);
    __hip_atomic_store(q + 1, (unsigned long long)w.z | ((unsigned long long)w.w << 32), __ATOMIC_RELAXED, __HIP_MEMORY_SCOPE_SYSTEM); }
__device__ __forceinline__ float sgm(float v) { return __builtin_amdgcn_rcpf(1.f + __expf(-v)); }
__device__ __forceinline__ float bflo(unsigned w) { return __uint_as_float(w << 16); }
__device__ __forceinline__ float bfhi(unsigned w) { return __uint_as_float(w & 0xffff0000u); }
__device__ __forceinline__ f32x4 shx4(const f32x4 v, int m) { f32x4 r; r[0] = __shfl_xor(v[0], m); r[1] = __shfl_xor(v[1], m); r[2] = __shfl_xor(v[2], m); r[3] = __shfl_xor(v[3], m); return r; }

struct EpiH {
    static constexpr bool PERM = true, AFTER_DRAIN = false;
    bf16_t *lat, *dq, *dk, *dv, *mq; const float *cosd, *sind, *cosm, *sinm;
    __device__ __forceinline__ void operator()(const f32x4 (&acc)[2][2][4][2], const Unit& u, int wr, int wc, int fr, int fq) const {
        const int pn = u.pn; bf16_t* base; int ld, c0, mode;
        if (pn < 3) { base = lat; ld = 768; c0 = pn * 256; mode = (pn == 2) ? 2 : 0; }
        else if (pn < 7) { base = dq; ld = 1024; c0 = (pn - 3) * 256; mode = 1; }
        else if (pn < 11) { base = dk; ld = 1024; c0 = (pn - 7) * 256; mode = 1; }
        else if (pn < 15) { base = dv; ld = 1024; c0 = (pn - 11) * 256; mode = 0; }
        else { base = mq; ld = 512; c0 = (pn - 15) * 256; mode = 0; }
        const int row0 = u.pm * BM + wr * 64 + fr, colw = c0 + wc * 32 + 8 * fq;
#pragma unroll
        for (int ai = 0; ai < 2; ++ai)
#pragma unroll
            for (int m = 0; m < 4; ++m) { const int row = row0 + ai * HALF + m * 16; bf16_t* rowp = base + (size_t)row * ld + colw;
#pragma unroll
                for (int bj = 0; bj < 2; ++bj) { f32x4 v0 = acc[ai][bj][m][0], v1 = acc[ai][bj][m][1];
                    if (mode == 1 && (wc & 1) == 0) {
                        const f32x4 p0 = shx4(v0, 16), p1 = shx4(v1, 16);
                        if (fq < 2) { const f32x4 c0v = *(const f32x4*)(cosd + (size_t)row * 8), c1v = *(const f32x4*)(cosd + (size_t)row * 8 + 4);
                            f32x4 s0v = *(const f32x4*)(sind + (size_t)row * 8), s1v = *(const f32x4*)(sind + (size_t)row * 8 + 4);
                            if (fq == 0) { s0v = -s0v; s1v = -s1v; }
                            v0 = v0 * c0v + p0 * s0v; v1 = v1 * c1v + p1 * s1v; } }
                    if (mode == 2 && bj == 1 && wc == 0) {
                        const f32x4 p0 = shx4(v0, 32), p1 = shx4(v1, 32); const int i16 = (fq & 1) * 8;
                        const f32x4 c0v = *(const f32x4*)(cosm + (size_t)row * 16 + i16), c1v = *(const f32x4*)(cosm + (size_t)row * 16 + i16 + 4);
                        f32x4 s0v = *(const f32x4*)(sinm + (size_t)row * 16 + i16), s1v = *(const f32x4*)(sinm + (size_t)row * 16 + i16 + 4);
                        if (fq < 2) { s0v = -s0v; s1v = -s1v; }
                        v0 = v0 * c0v + p0 * s0v; v1 = v1 * c1v + p1 * s1v; }
                    *(u32x4*)(rowp + bj * HALF) = pack8(v0, v1); }
                asm volatile("" ::: "memory"); }
    }
};
template <bool ROPE> struct EpiScale {
    static constexpr bool PERM = true, AFTER_DRAIN = false;
    bf16_t* O; int ld; const float* rs; const float *cosm, *sinm;
    __device__ __forceinline__ void operator()(const f32x4 (&acc)[2][2][4][2], const Unit& u, int wr, int wc, int fr, int fq) const {
        const int row0 = u.pm * BM + wr * 64 + fr, colw = u.pn * BM + wc * 32 + 8 * fq;
#pragma unroll
        for (int ai = 0; ai < 2; ++ai)
#pragma unroll
            for (int m = 0; m < 4; ++m) { const int row = row0 + ai * HALF + m * 16; bf16_t* rowp = O + (size_t)row * ld + colw;
                const float sc = rs ? __hip_atomic_load(rs + row, __ATOMIC_RELAXED, __HIP_MEMORY_SCOPE_AGENT) : 1.f;
#pragma unroll
                for (int bj = 0; bj < 2; ++bj) { f32x4 v0 = acc[ai][bj][m][0] * sc, v1 = acc[ai][bj][m][1] * sc;
                    if (ROPE && u.pn == 2) {
                        const f32x4 p0 = shx4(v0, 32), p1 = shx4(v1, 32); const int i16 = (fq & 1) * 8;
                        const f32x4 c0v = *(const f32x4*)(cosm + (size_t)row * 16 + i16), c1v = *(const f32x4*)(cosm + (size_t)row * 16 + i16 + 4);
                        f32x4 s0v = *(const f32x4*)(sinm + (size_t)row * 16 + i16), s1v = *(const f32x4*)(sinm + (size_t)row * 16 + i16 + 4);
                        if (fq < 2) { s0v = -s0v; s1v = -s1v; }
                        v0 = v0 * c0v + p0 * s0v; v1 = v1 * c1v + p1 * s1v; }
                    *(u32x4*)(rowp + bj * HALF) = pack8(v0, v1); }
                asm volatile("" ::: "memory"); }
    }
};
struct EpiGate {
    static constexpr bool PERM = true, AFTER_DRAIN = false;
    bf16_t* G; const float* bias;
    __device__ __forceinline__ void operator()(const f32x4 (&acc)[2][2][4][2], const Unit& u, int wr, int wc, int fr, int fq) const {
        const int row0 = u.pm * BM + wr * 64 + fr, colw = u.pn * BM + wc * 32 + 8 * fq;
        f32x4 bv[2][2];
#pragma unroll
        for (int bj = 0; bj < 2; ++bj)
#pragma unroll
            for (int n = 0; n < 2; ++n) bv[bj][n] = *(const f32x4*)(bias + colw + bj * HALF + 4 * n);
#pragma unroll
        for (int ai = 0; ai < 2; ++ai)
#pragma unroll
            for (int m = 0; m < 4; ++m) { bf16_t* rowp = G + (size_t)(row0 + ai * HALF + m * 16) * 1024 + colw;
#pragma unroll
                for (int bj = 0; bj < 2; ++bj) { f32x4 v0 = acc[ai][bj][m][0] + bv[bj][0], v1 = acc[ai][bj][m][1] + bv[bj][1];
                    *(u32x4*)(rowp + bj * HALF) = pack8(v0, v1); }
                asm volatile("" ::: "memory"); }
    }
};
template <bool FIRST> struct EpiBranch {
    static constexpr bool PERM = true, AFTER_DRAIN = false;
    const bf16_t* G; bf16_t* Mg;
    __device__ __forceinline__ void operator()(const f32x4 (&acc)[2][2][4][2], const Unit& u, int wr, int wc, int fr, int fq) const {
        const int row0 = u.pm * BM + wr * 64 + fr, colw = u.pn * BM + wc * 32 + 8 * fq;
#pragma unroll
        for (int ai = 0; ai < 2; ++ai)
#pragma unroll
            for (int m = 0; m < 4; ++m) { const size_t off = (size_t)(row0 + ai * HALF + m * 16) * 1024 + colw;
#pragma unroll
                for (int bj = 0; bj < 2; ++bj) { const u32x4 g = *(const u32x4*)(G + off + bj * HALF);
                    f32x4 v0 = acc[ai][bj][m][0], v1 = acc[ai][bj][m][1];
                    v0[0] *= sgm(bflo(g.x)); v0[1] *= sgm(bfhi(g.x)); v0[2] *= sgm(bflo(g.y)); v0[3] *= sgm(bfhi(g.y)); v1[0] *= sgm(bflo(g.z)); v1[1] *= sgm(bfhi(g.z)); v1[2] *= sgm(bflo(g.w)); v1[3] *= sgm(bfhi(g.w));
                    if (!FIRST) { const u32x4 o = *(const u32x4*)(Mg + off + bj * HALF);
                        v0[0] += bflo(o.x); v0[1] += bfhi(o.x); v0[2] += bflo(o.y); v0[3] += bfhi(o.y); v1[0] += bflo(o.z); v1[1] += bfhi(o.z); v1[2] += bflo(o.w); v1[3] += bfhi(o.w); }
                    *(u32x4*)(Mg + off + bj * HALF) = pack8(v0, v1); }
                asm volatile("" ::: "memory"); }
    }
};
struct EpiRes {
    static constexpr bool PERM = false, AFTER_DRAIN = false;
    float* X; float alpha;
    __device__ __forceinline__ void operator()(const f32x4 (&acc)[2][2][4][2], const Unit& u, int wr, int wc, int fr, int fq) const {
        const int row0 = u.pm * BM + wr * 64 + fr, col0 = u.pn * BM + wc * 32 + 4 * fq;
        float* base = X + (size_t)row0 * 1024 + col0;
        f32x4 xq[2][2][2];
#pragma unroll
        for (int bj = 0; bj < 2; ++bj)
#pragma unroll
            for (int n = 0; n < 2; ++n) xq[0][bj][n] = *(const f32x4*)(base + bj * HALF + n * 16);
#pragma unroll
        for (int it = 0; it < 8; ++it) { const int ai = it >> 2, m = it & 3, cur = it & 1; float* rowp = base + (size_t)(ai * HALF + m * 16) * 1024;
            if (it < 7) { const float* rown = base + (size_t)(((it + 1) >> 2) * HALF + ((it + 1) & 3) * 16) * 1024;
#pragma unroll
                for (int bj = 0; bj < 2; ++bj)
#pragma unroll
                    for (int n = 0; n < 2; ++n) xq[cur ^ 1][bj][n] = *(const f32x4*)(rown + bj * HALF + n * 16); }
#pragma unroll
            for (int bj = 0; bj < 2; ++bj)
#pragma unroll
                for (int n = 0; n < 2; ++n) *(f32x4*)(rowp + bj * HALF + n * 16) = xq[cur][bj][n] * alpha + acc[ai][bj][m][n];
            asm volatile("" ::: "memory"); }
    }
};
struct EpiRelu2 {
    static constexpr bool PERM = true, AFTER_DRAIN = false;
    bf16_t* H; int ld;
    __device__ __forceinline__ void operator()(const f32x4 (&acc)[2][2][4][2], const Unit& u, int wr, int wc, int fr, int fq) const {
        const int row0 = u.pm * BM + wr * 64 + fr, colw = u.pn * BM + wc * 32 + 8 * fq;
#pragma unroll
        for (int ai = 0; ai < 2; ++ai)
#pragma unroll
            for (int m = 0; m < 4; ++m) { bf16_t* rowp = H + (size_t)(row0 + ai * HALF + m * 16) * ld + colw;
#pragma unroll
                for (int bj = 0; bj < 2; ++bj) { f32x4 v0 = acc[ai][bj][m][0], v1 = acc[ai][bj][m][1];
#pragma unroll
                    for (int e = 0; e < 4; ++e) { const float a = fmaxf(v0[e], 0.f), b = fmaxf(v1[e], 0.f); v0[e] = a * a; v1[e] = b * b; }
                    *(u32x4*)(rowp + bj * HALF) = pack8(v0, v1); }
                asm volatile("" ::: "memory"); }
    }
};

template <class Epi, class Sched, bool ALIGN_EPI = false, bool SP2 = false>
__device__ __forceinline__ void gemm_phase(PG8_LAS unsigned char* lds, const Gemm g, const Sched& S, const Epi& E) {
    int tid_ = threadIdx.x; asm volatile("" : "+v"(tid_));
    const int tid = tid_, wid = __builtin_amdgcn_readfirstlane(tid >> 6), lane = tid & 63, wr = wid >> 2, wc = wid & 3, fr = lane & 15, fq = lane >> 4;
    int K_ = g.K; asm volatile("" : "+s"(K_));
    const int K = K_, nt = K / BK;
    unsigned voffA[2], voffB[2];
#pragma unroll
    for (int i = 0; i < 2; ++i) { int R, C; stage_rc(tid * 16 + i * 8192, R, C); const int Rb = Epi::PERM ? ((R & ~31) + perm32(R & 31)) : R;
        voffA[i] = (unsigned)(R * g.lda + C) * 2u; voffB[i] = (unsigned)(Rb * g.ldb + C) * 2u; }
    const size_t kstep = (size_t)(BK * 2);
    const size_t hstepA = (size_t)HALF * g.lda * 2, hstepB = (size_t)HALF * g.ldb * 2;
    const size_t tstepA = 2 * hstepA, tstepB = 2 * hstepB;
    const unsigned ldsw = (unsigned)wid * 1024u;
    const int aoff = lds_byte(wr * 64 + fr, fq * 8), boff = lds_byte(wc * 32 + fr, fq * 8);
#define PG8_SA(b, h) (((b) * 2 + (h)) * HTB)
#define PG8_SB(b, h) ((4 + (b) * 2 + (h)) * HTB)
#define PG8_STAGE(bufoff, gbase, voff) do { _Pragma("unroll") for (int _i = 0; _i < 2; ++_i) \
        __builtin_amdgcn_global_load_lds((const unsigned*)((const char*)(gbase) + (voff)[_i]), (PG8_LAS unsigned*)(lds + (bufoff) + ldsw + _i * 8192), 16, 0, 0); } while (0)
#define PG8_LDA(dst, b, h) do { _Pragma("unroll") for (int m = 0; m < 4; ++m) _Pragma("unroll") for (int k = 0; k < 2; ++k) dst[m][k] = *(const PG8_LAS bf16x8*)(lds + PG8_SA(b, h) + aoff + m * 2048 + k * 1024); } while (0)
#define PG8_LDB(dst, b, h) do { _Pragma("unroll") for (int n = 0; n < 2; ++n) _Pragma("unroll") for (int k = 0; k < 2; ++k) dst[n][k] = *(const PG8_LAS bf16x8*)(lds + PG8_SB(b, h) + boff + n * 2048 + k * 1024); } while (0)
#define PG8_MMA(ai, bj, At, Bt) do { __builtin_amdgcn_s_setprio(1); _Pragma("unroll") for (int m = 0; m < 4; ++m) _Pragma("unroll") for (int n = 0; n < 2; ++n) _Pragma("unroll") for (int k = 0; k < 2; ++k) \
        acc[ai][bj][m][n] = __builtin_amdgcn_mfma_f32_16x16x32_bf16(Bt[n][k], At[m][k], acc[ai][bj][m][n], 0, 0, 0); __builtin_amdgcn_s_setprio(0); } while (0)
#define PG8_WAIT_V(n) asm volatile("s_waitcnt vmcnt(" #n ")" ::: "memory")
#define PG8_WAIT_L(n) asm volatile("s_waitcnt lgkmcnt(" #n ")" ::: "memory")
#define PG8_BAR __builtin_amdgcn_s_barrier()
#define PG8_SCHED __builtin_amdgcn_sched_barrier(0)
    Unit cur, nxt; int ui = 0;
    if (!S.next(0, cur)) return;
    f32x4 acc[2][2][4][2];
#pragma unroll
    for (int a = 0; a < 2; ++a)
#pragma unroll
        for (int b = 0; b < 2; ++b)
#pragma unroll
            for (int m = 0; m < 4; ++m)
#pragma unroll
                for (int n = 0; n < 2; ++n) acc[a][b][m][n] = (f32x4){0.f, 0.f, 0.f, 0.f};
    bf16x8 At[4][2], B0[2][2], B1[2][2];
    const char* cA = (const char*)g.A + (size_t)cur.pm * tstepA; const char* cB = (const char*)g.Bt + (size_t)cur.pn * tstepB;
    S.a_ready(cur);
    if constexpr (SP2) {
        PG8_STAGE(PG8_SB(0, 0), cB, voffB); PG8_STAGE(PG8_SB(0, 1), cB + hstepB, voffB); PG8_STAGE(PG8_SA(0, 0), cA, voffA); PG8_STAGE(PG8_SA(0, 1), cA + hstepA, voffA);
        if (wr == 1) PG8_BAR;
        PG8_WAIT_V(2); PG8_BAR;
        PG8_STAGE(PG8_SB(1, 0), cB + kstep, voffB); PG8_STAGE(PG8_SA(1, 0), cA + kstep, voffA); PG8_STAGE(PG8_SB(1, 1), cB + hstepB + kstep, voffB);
        PG8_WAIT_V(6); PG8_BAR;
    } else {
        PG8_STAGE(PG8_SB(0, 0), cB, voffB); PG8_STAGE(PG8_SA(0, 0), cA, voffA); PG8_STAGE(PG8_SB(0, 1), cB + hstepB, voffB); PG8_STAGE(PG8_SA(0, 1), cA + hstepA, voffA);
        if (wr == 1) PG8_BAR;
        PG8_WAIT_V(4); PG8_BAR;
        PG8_STAGE(PG8_SB(1, 0), cB + kstep, voffB); PG8_STAGE(PG8_SA(1, 0), cA + kstep, voffA); PG8_STAGE(PG8_SB(1, 1), cB + hstepB + kstep, voffB);
        PG8_WAIT_V(6); PG8_BAR;
    }
    for (;;) {
        const bool has_next = S.next(ui + 1, nxt);
        const char* nA = has_next ? (const char*)g.A + (size_t)nxt.pm * tstepA : cA; const char* nB = has_next ? (const char*)g.Bt + (size_t)nxt.pn * tstepB : cB;
        for (int t = 0; t < nt; t += 2) {
            const bool last = (t == nt - 2);
            const char* a1 = cA + (size_t)(t + 1) * kstep;
            const char* a2 = last ? nA : cA + (size_t)(t + 2) * kstep; const char* b2 = last ? nB : cB + (size_t)(t + 2) * kstep;
            const char* a3 = a2 + kstep; const char* b3 = b2 + kstep;
            if (last && has_next) S.a_ready(nxt);
            if constexpr (SP2) {
            PG8_LDB(B0, 0, 0); PG8_LDB(B1, 0, 1); PG8_SCHED; PG8_LDA(At, 0, 0); PG8_STAGE(PG8_SA(1, 1), a1 + hstepA, voffA);
            PG8_WAIT_V(8); PG8_WAIT_L(0); PG8_BAR; PG8_MMA(0, 0, At, B0); PG8_MMA(0, 1, At, B1); PG8_BAR; PG8_SCHED;
            PG8_LDA(At, 0, 1); PG8_STAGE(PG8_SB(0, 0), b2, voffB); PG8_STAGE(PG8_SB(0, 1), b2 + hstepB, voffB); PG8_STAGE(PG8_SA(0, 0), a2, voffA);
            PG8_WAIT_V(8); PG8_WAIT_L(0); PG8_BAR; PG8_MMA(1, 0, At, B0); PG8_MMA(1, 1, At, B1); PG8_BAR; PG8_SCHED;
            PG8_LDB(B0, 1, 0); PG8_LDB(B1, 1, 1); PG8_SCHED; PG8_LDA(At, 1, 0); PG8_STAGE(PG8_SA(0, 1), a2 + hstepA, voffA);
            PG8_WAIT_V(8); PG8_WAIT_L(0); PG8_BAR; PG8_MMA(0, 0, At, B0); PG8_MMA(0, 1, At, B1); PG8_BAR; PG8_SCHED;
            PG8_LDA(At, 1, 1); PG8_STAGE(PG8_SB(1, 0), b3, voffB); PG8_STAGE(PG8_SB(1, 1), b3 + hstepB, voffB); PG8_STAGE(PG8_SA(1, 0), a3, voffA);
            PG8_WAIT_V(8); PG8_WAIT_L(0); PG8_BAR; PG8_MMA(1, 0, At, B0); PG8_MMA(1, 1, At, B1); PG8_BAR; PG8_SCHED;
            } else {
            PG8_LDB(B0, 0, 0); PG8_SCHED; PG8_LDA(At, 0, 0); PG8_STAGE(PG8_SA(1, 1), a1 + hstepA, voffA);
            PG8_WAIT_L(8); PG8_BAR; PG8_WAIT_L(0); PG8_MMA(0, 0, At, B0); PG8_BAR; PG8_SCHED;
            PG8_LDB(B1, 0, 1); PG8_STAGE(PG8_SB(0, 0), b2, voffB);
            PG8_BAR; PG8_WAIT_L(0); PG8_MMA(0, 1, At, B1); PG8_BAR;
            PG8_LDA(At, 0, 1); PG8_STAGE(PG8_SA(0, 0), a2, voffA);
            PG8_BAR; PG8_WAIT_L(0); PG8_MMA(1, 0, At, B0); PG8_BAR; PG8_SCHED;
            PG8_STAGE(PG8_SB(0, 1), b2 + hstepB, voffB);
            PG8_WAIT_V(6); PG8_BAR; PG8_MMA(1, 1, At, B1); PG8_BAR;
            PG8_LDB(B0, 1, 0); PG8_SCHED; PG8_LDA(At, 1, 0); PG8_STAGE(PG8_SA(0, 1), a2 + hstepA, voffA);
            PG8_WAIT_L(8); PG8_BAR; PG8_WAIT_L(0); PG8_MMA(0, 0, At, B0); PG8_BAR; PG8_SCHED;
            PG8_LDB(B1, 1, 1); PG8_STAGE(PG8_SB(1, 0), b3, voffB);
            PG8_BAR; PG8_WAIT_L(0); PG8_MMA(0, 1, At, B1); PG8_BAR;
            PG8_LDA(At, 1, 1); PG8_STAGE(PG8_SA(1, 0), a3, voffA);
            PG8_BAR; PG8_WAIT_L(0); PG8_MMA(1, 0, At, B0); PG8_BAR; PG8_SCHED;
            PG8_STAGE(PG8_SB(1, 1), b3 + hstepB, voffB);
            PG8_WAIT_V(6); PG8_BAR; PG8_MMA(1, 1, At, B1); PG8_BAR;
            }
        }
        if constexpr (ALIGN_EPI) { if (wr == 0) PG8_BAR; }
        if constexpr (!Epi::AFTER_DRAIN) { E(acc, cur, wr, wc, fr, fq); S.done(cur); }
        if (!has_next) break;
#pragma unroll
        for (int a = 0; a < 2; ++a)
#pragma unroll
            for (int b = 0; b < 2; ++b)
#pragma unroll
                for (int m = 0; m < 4; ++m)
#pragma unroll
                    for (int n = 0; n < 2; ++n) acc[a][b][m][n] = (f32x4){0.f, 0.f, 0.f, 0.f};
        cur = nxt; cA = nA; cB = nB; ++ui;
        if constexpr (ALIGN_EPI) { if (wr == 1) PG8_BAR; }
    }
    PG8_WAIT_V(0);
    if constexpr (!ALIGN_EPI) { if (wr == 0) PG8_BAR; }
    PG8_BAR;
    if constexpr (Epi::AFTER_DRAIN) { E.fused(acc, cur, wr, wc, fr, fq, lds, wid, lane); S.done(cur); }
#undef PG8_SA
#undef PG8_SB
#undef PG8_STAGE
#undef PG8_LDA
#undef PG8_LDB
#undef PG8_MMA
#undef PG8_WAIT_V
#undef PG8_WAIT_L
#undef PG8_BAR
#undef PG8_SCHED
}
}

namespace att {
#define LAS __attribute__((address_space(3)))
typedef unsigned short bf16_t;
typedef LAS char* lptr;
using bf16x8 = __attribute__((ext_vector_type(8))) short;
using s16x4  = __attribute__((ext_vector_type(4))) short;
using f32x16 = __attribute__((ext_vector_type(16))) float;
using u32x4  = __attribute__((ext_vector_type(4))) unsigned;
constexpr int V_OFF = 0, K_OFF = 32768, WS_OFF = 67584, STASH_OFF = 69632, ATT_LDS_END = STASH_OFF + 65536;
#define SBAR() __builtin_amdgcn_sched_barrier(0)
__device__ __forceinline__ int crow(int r, int hi) { return (r & 3) + 8 * (r >> 2) + 4 * hi; }
__device__ __forceinline__ unsigned cvtpk(float lo, float hi) { unsigned r; asm volatile("v_cvt_pk_bf16_f32 %0, %1, %2" : "=v"(r) : "v"(lo), "v"(hi)); return r; }
__device__ __forceinline__ unsigned short f2bf(float f) { unsigned u = __builtin_bit_cast(unsigned, f); return (unsigned short)((u + 0x7fffu + ((u >> 16) & 1u)) >> 16); }

struct Args { const bf16_t *Q0, *Q1, *K0, *K1, *V; int ldq, ldk0, ldk1, ldv, nkeys; float C, thr; };

__device__ __forceinline__ void partialSM(f32x16& p0, f32x16& p1, float& m_reg, float& mn, float& alpha, float C, float thr) {
  float pmax = p0[0];
#pragma unroll
  for (int r = 1; r < 16; ++r) pmax = fmaxf(pmax, p0[r]);
#pragma unroll
  for (int r = 0; r < 16; ++r) pmax = fmaxf(pmax, p1[r]);
  { auto rr = __builtin_amdgcn_permlane32_swap(__float_as_uint(pmax), __float_as_uint(pmax), false, false);
    pmax = fmaxf(__uint_as_float(rr[0]), __uint_as_float(rr[1])); }
  if (__builtin_expect(__all(pmax - m_reg <= thr), 1)) { mn = m_reg; alpha = 1.f; }
  else { mn = fmaxf(m_reg, pmax); alpha = __builtin_amdgcn_exp2f((m_reg - mn) * C); m_reg = mn; }
  const float mnC = -mn * C;
#pragma unroll
  for (int r = 0; r < 16; ++r) p0[r] = fmaf(p0[r], C, mnC);
#pragma unroll
  for (int r = 0; r < 16; ++r) p1[r] = fmaf(p1[r], C, mnC);
#pragma unroll
  for (int r = 0; r < 16; ++r) p0[r] = __builtin_amdgcn_exp2f(p0[r]);
}
__device__ __forceinline__ void finishSM(f32x16& p0, f32x16& p1, float alpha, float& l_reg, bf16x8& pa0, bf16x8& pa1, bf16x8& pa2, bf16x8& pa3) {
#pragma unroll
  for (int r = 0; r < 16; ++r) p1[r] = __builtin_amdgcn_exp2f(p1[r]);
  float ps = 0;
#pragma unroll
  for (int r = 0; r < 16; ++r) ps += p0[r];
#pragma unroll
  for (int r = 0; r < 16; ++r) ps += p1[r];
  { auto rr = __builtin_amdgcn_permlane32_swap(__float_as_uint(ps), __float_as_uint(ps), false, false);
    ps = __uint_as_float(rr[0]) + __uint_as_float(rr[1]); }
  l_reg = l_reg * alpha + ps;
#define PK4(P, BASE, OUT) do { unsigned a0 = cvtpk(P[BASE + 0], P[BASE + 1]), a1 = cvtpk(P[BASE + 2], P[BASE + 3]);   \
    unsigned b0 = cvtpk(P[BASE + 4], P[BASE + 5]), b1 = cvtpk(P[BASE + 6], P[BASE + 7]);                              \
    auto r0 = __builtin_amdgcn_permlane32_swap(a0, b0, false, false); auto r1 = __builtin_amdgcn_permlane32_swap(a1, b1, false, false); \
    u32x4 w = {r0[0], r1[0], r0[1], r1[1]}; OUT = __builtin_bit_cast(bf16x8, w); } while (0)
  PK4(p0, 0, pa0); PK4(p0, 8, pa1); PK4(p1, 0, pa2); PK4(p1, 8, pa3);
#undef PK4
}
template <int NQ, int KROW> __device__ __forceinline__ void qkt(f32x16& p0, f32x16& p1, lptr Ks, const bf16x8* qr, int r32, int hi) {
  p0 = f32x16{}; p1 = f32x16{};
#pragma unroll
  for (int d0 = 0; d0 < NQ; ++d0) { const int cb = (d0 * 16 + hi * 8) * 2;
    const bf16x8 b0 = *(const LAS bf16x8*)(Ks + r32 * KROW + cb);
    const bf16x8 b1 = *(const LAS bf16x8*)(Ks + (32 + r32) * KROW + cb);
    p0 = __builtin_amdgcn_mfma_f32_32x32x16_bf16(b0, qr[d0], p0, 0, 0, 0);
    p1 = __builtin_amdgcn_mfma_f32_32x32x16_bf16(b1, qr[d0], p1, 0, 0, 0); }
}
template <int ND> __device__ __forceinline__ int v_st(int k, int c) { const int kk = (k & ~0xC) | ((k & 4) << 1) | ((k & 8) >> 1); return ((kk >> 3) * ND + (c >> 5)) * 512 + ((kk & 7) * 32 + (c & 31)) * 2; }
__device__ __forceinline__ int v_rd_base(int lane) { return ((lane & 3) << 3) | (((lane >> 2) & 3) << 6) | (((lane >> 4) & 1) << 5) | (((lane >> 5) & 1) << 8); }
template <int OFF> __device__ __forceinline__ s16x4 tr_read(int vb) {
  s16x4 r; asm volatile("ds_read_b64_tr_b16 %0, %1 offset:%2" : "=&v"(r) : "v"(vb), "i"(OFF) : "memory"); return r;
}
template <int ND, int D0> __device__ __forceinline__ void pv_one(f32x16& od, int vb, bf16x8 pa0, bf16x8 pa1, bf16x8 pa2, bf16x8 pa3) {
  constexpr int KG = ND * 512;
  const s16x4 l0 = tr_read<D0 * 512 + 0 * KG>(vb), h0 = tr_read<D0 * 512 + 1 * KG>(vb), l1 = tr_read<D0 * 512 + 2 * KG>(vb), h1 = tr_read<D0 * 512 + 3 * KG>(vb);
  const s16x4 l2 = tr_read<D0 * 512 + 4 * KG>(vb), h2 = tr_read<D0 * 512 + 5 * KG>(vb), l3 = tr_read<D0 * 512 + 6 * KG>(vb), h3 = tr_read<D0 * 512 + 7 * KG>(vb);
  asm volatile("s_waitcnt lgkmcnt(0)" ::: "memory"); SBAR();
#define PK(L, H) (bf16x8){L[0], L[1], L[2], L[3], H[0], H[1], H[2], H[3]}
  od = __builtin_amdgcn_mfma_f32_32x32x16_bf16(pa0, PK(l0, h0), od, 0, 0, 0);
  od = __builtin_amdgcn_mfma_f32_32x32x16_bf16(pa1, PK(l1, h1), od, 0, 0, 0);
  od = __builtin_amdgcn_mfma_f32_32x32x16_bf16(pa2, PK(l2, h2), od, 0, 0, 0);
  od = __builtin_amdgcn_mfma_f32_32x32x16_bf16(pa3, PK(l3, h3), od, 0, 0, 0);
#undef PK
}
template <int ND> __device__ __forceinline__ void pv_all(f32x16* o, int vb, bf16x8 pa0, bf16x8 pa1, bf16x8 pa2, bf16x8 pa3) {
  pv_one<ND, 0>(o[0], vb, pa0, pa1, pa2, pa3); pv_one<ND, 1>(o[1], vb, pa0, pa1, pa2, pa3);
  if constexpr (ND == 4) { pv_one<ND, 2>(o[2], vb, pa0, pa1, pa2, pa3); pv_one<ND, 3>(o[3], vb, pa0, pa1, pa2, pa3); }
}

template <int MODE> struct Cfg;
template <> struct Cfg<0> { static constexpr int DQK = 96, DV = 64; };
template <> struct Cfg<1> { static constexpr int DQK = 64, DV = 128; };
template <> struct Cfg<2> { static constexpr int DQK = 128, DV = 128; };

struct Slot { bf16x8 a, b, c, d; };

template <int MODE>
__device__ __forceinline__ void attn_core(const Args& A, lptr lds, f32x16* o, float* rli) {
  constexpr int DQK = Cfg<MODE>::DQK, DV = Cfg<MODE>::DV, NQ = DQK / 16, ND = DV / 32, KROW = DQK * 2 + 16, SHM_K = 64 * KROW, SHM_V = 64 * DV * 2;
  int tid_ = threadIdx.x; asm volatile("" : "+v"(tid_));
  const int tid = tid_, wid = tid >> 6, lane = tid & 63, r32 = lane & 31, hi = lane >> 5;
  const lptr V_lds = lds + V_OFF, K_lds = lds + K_OFF;
  LAS float* ws = (LAS float*)(lds + WS_OFF) + wid * 64; LAS float* li_l = ws; LAS float* al_l = ws + 32;
  float m_reg = -1e30f, l_reg = 0.f;
#pragma unroll
  for (int d = 0; d < ND; ++d) o[d] = f32x16{};
  bf16x8 qr[NQ];
  { const bf16_t* Qw = A.Q0 + (size_t)(wid * 32 + r32) * A.ldq + hi * 8;
    if constexpr (MODE == 0) {
#pragma unroll
      for (int d0 = 0; d0 < 4; ++d0) qr[d0] = *(const bf16x8*)(Qw + d0 * 16);
      const bf16_t* Qw1 = A.Q1 + (size_t)(wid * 32 + r32) * A.ldq + hi * 8;
      qr[4] = *(const bf16x8*)(Qw1); qr[5] = *(const bf16x8*)(Qw1 + 16);
    } else {
#pragma unroll
      for (int d0 = 0; d0 < NQ; ++d0) qr[d0] = *(const bf16x8*)(Qw + d0 * 16);
    } }
  const int vb0 = (int)(uintptr_t)V_lds + v_rd_base(lane);
  Slot sr_[2];
  const int r8 = tid >> 3, c8 = (tid & 7) * 8;
  const int r16 = tid >> 4, c16 = (tid & 15) * 8;
  const int rr4 = (tid & 255) >> 2, cr4 = (tid & 3) * 8;
#define SLOAD(i, k0) do { \
    if constexpr (MODE == 0) { sr_[i].a = *(const bf16x8*)(A.K0 + (size_t)((k0) + r8) * A.ldk0 + c8); sr_[i].b = *(const bf16x8*)(A.K1 + (size_t)((k0) + rr4) * A.ldk1 + cr4); \
                               sr_[i].c = *(const bf16x8*)(A.V + (size_t)((k0) + r8) * A.ldv + c8); } \
    else if constexpr (MODE == 1) { sr_[i].a = *(const bf16x8*)(A.K0 + (size_t)((k0) + r8) * A.ldk0 + c8); \
                               sr_[i].c = *(const bf16x8*)(A.V + (size_t)((k0) + r16) * A.ldv + c16); sr_[i].d = *(const bf16x8*)(A.V + (size_t)((k0) + 32 + r16) * A.ldv + c16); } \
    else { sr_[i].a = *(const bf16x8*)(A.K0 + (size_t)((k0) + r16) * A.ldk0 + c16); sr_[i].b = *(const bf16x8*)(A.K0 + (size_t)((k0) + 32 + r16) * A.ldk0 + c16); \
           sr_[i].c = *(const bf16x8*)(A.V + (size_t)((k0) + r16) * A.ldv + c16); sr_[i].d = *(const bf16x8*)(A.V + (size_t)((k0) + 32 + r16) * A.ldv + c16); } } while (0)
#define SWRITE(bf, i) do { const lptr Kb = K_lds + (bf) * SHM_K; const lptr Vb = V_lds + (bf) * SHM_V; \
    if constexpr (MODE == 0) { *(LAS bf16x8*)(Kb + r8 * KROW + c8 * 2) = sr_[i].a; if (tid < 256) *(LAS bf16x8*)(Kb + rr4 * KROW + 128 + cr4 * 2) = sr_[i].b; \
                               *(LAS bf16x8*)(Vb + v_st<ND>(r8, c8)) = sr_[i].c; } \
    else if constexpr (MODE == 1) { *(LAS bf16x8*)(Kb + r8 * KROW + c8 * 2) = sr_[i].a; \
                               *(LAS bf16x8*)(Vb + v_st<ND>(r16, c16)) = sr_[i].c; *(LAS bf16x8*)(Vb + v_st<ND>(32 + r16, c16)) = sr_[i].d; } \
    else { *(LAS bf16x8*)(Kb + r16 * KROW + c16 * 2) = sr_[i].a; *(LAS bf16x8*)(Kb + (32 + r16) * KROW + c16 * 2) = sr_[i].b; \
           *(LAS bf16x8*)(Vb + v_st<ND>(r16, c16)) = sr_[i].c; *(LAS bf16x8*)(Vb + v_st<ND>(32 + r16, c16)) = sr_[i].d; } } while (0)
#define SWAIT() do { if constexpr (MODE == 2) asm volatile("s_waitcnt vmcnt(4)" ::: "memory"); else asm volatile("s_waitcnt vmcnt(3)" ::: "memory"); } while (0)
#define ATT_BAR() asm volatile("s_waitcnt lgkmcnt(0)\n\ts_barrier" ::: "memory")
#define RESC(a) do { if (__any((a) < 1.f)) { if (hi == 0) al_l[r32] = (a); asm volatile("s_waitcnt lgkmcnt(0)" ::: "memory"); \
    _Pragma("unroll") for (int d = 0; d < ND; ++d) _Pragma("unroll") for (int r = 0; r < 16; ++r) o[d][r] *= al_l[crow(r, hi)]; } } while (0)
  f32x16 pA0, pA1, pB0, pB1; float mnA, mnB, alA, alB; bf16x8 pa0, pa1, pa2, pa3; const int NT = A.nkeys / 64;
  const float C = A.C, thr = A.thr;
  SLOAD(0, 0); asm volatile("s_waitcnt vmcnt(0)" ::: "memory"); SWRITE(0, 0); ATT_BAR();
  qkt<NQ, KROW>(pA0, pA1, K_lds, qr, r32, hi); partialSM(pA0, pA1, m_reg, mnA, alA, C, thr);
  SLOAD(1, 64); if (2 < NT) SLOAD(0, 128);
  SWAIT(); SWRITE(1, 1); ATT_BAR();
  for (int j = 1; j + 1 < NT; j += 2) {
    SBAR(); qkt<NQ, KROW>(pB0, pB1, K_lds + SHM_K, qr, r32, hi);
    finishSM(pA0, pA1, alA, l_reg, pa0, pa1, pa2, pa3); SBAR();
    SLOAD(1, (j + 2) * 64); SBAR();
    pv_all<ND>(o, vb0, pa0, pa1, pa2, pa3); partialSM(pB0, pB1, m_reg, mnB, alB, C, thr);
    ATT_BAR(); SWAIT(); SWRITE(0, 0);
    RESC(alB); ATT_BAR();
    SBAR(); qkt<NQ, KROW>(pA0, pA1, K_lds, qr, r32, hi);
    finishSM(pB0, pB1, alB, l_reg, pa0, pa1, pa2, pa3); SBAR();
    if (j + 3 < NT) SLOAD(0, (j + 3) * 64); SBAR();
    pv_all<ND>(o, vb0 + SHM_V, pa0, pa1, pa2, pa3); partialSM(pA0, pA1, m_reg, mnA, alA, C, thr);
    ATT_BAR(); SWAIT(); SWRITE(1, 1);
    RESC(alA); ATT_BAR();
  }
  SBAR(); qkt<NQ, KROW>(pB0, pB1, K_lds + SHM_K, qr, r32, hi);
  finishSM(pA0, pA1, alA, l_reg, pa0, pa1, pa2, pa3); SBAR();
  pv_all<ND>(o, vb0, pa0, pa1, pa2, pa3); partialSM(pB0, pB1, m_reg, mnB, alB, C, thr);
  ATT_BAR(); RESC(alB);
  finishSM(pB0, pB1, alB, l_reg, pa0, pa1, pa2, pa3); SBAR();
  pv_all<ND>(o, vb0 + SHM_V, pa0, pa1, pa2, pa3);
  if (hi == 0) li_l[r32] = l_reg; asm volatile("s_waitcnt lgkmcnt(0)" ::: "memory");
#pragma unroll
  for (int r = 0; r < 16; ++r) rli[r] = __builtin_amdgcn_rcpf(li_l[crow(r, hi)]);
  ATT_BAR();
#undef SLOAD
#undef SWRITE
#undef SWAIT
#undef RESC
#undef ATT_BAR
}
}

typedef unsigned short bf16;
typedef float f32x4 __attribute__((ext_vector_type(4)));
typedef unsigned v4u __attribute__((ext_vector_type(4)));
constexpr int T = 32768, DM = 1024, SEQ = 2048, NBATCH = 16, DEPTH = 4, MEMLEN = 256, NIN = 7328, DFF = 4096;
constexpr int NWAVES = 8, NTHREADS = 512;
constexpr float ALPHA = 1.6817928305074290f;
constexpr int LDS_BYTES = 139264;
static_assert(att::ATT_LDS_END <= LDS_BYTES && pg8::STAGE_BYTES <= LDS_BYTES, "LDS map");
constexpr size_t MiB = 1u << 20;
constexpr size_t WS_BAR = 512 * 1024;
constexpr size_t WS_RSQ = 0, WS_RSKV = 256 * 1024;
constexpr size_t WS_COSM = 1 * MiB, WS_SINM = 3 * MiB, WS_COSD = 5 * MiB, WS_SIND = 6 * MiB;
constexpr size_t WS_W = 8 * MiB;
constexpr size_t WS_MEMB = 48 * MiB, WS_MEMKV = 56 * MiB, WS_XB = 64 * MiB;
constexpr size_t WS_DQ = 128 * MiB, WS_MQ = 192 * MiB, WS_QM = 224 * MiB, WS_LAT = 272 * MiB, WS_DK = 320 * MiB, WS_DV = 384 * MiB, WS_KVM = 448 * MiB, WS_END = 512 * MiB;
constexpr size_t WS_G = 272 * MiB, WS_MG = 336 * MiB;
constexpr size_t WS_HID = 128 * MiB;
constexpr size_t WO_IN = 0, WO_G = WO_IN + (size_t)4352 * 1024, WO_UQ = WO_G + (size_t)3072 * 1024, WO_UKV = WO_UQ + (size_t)768 * 384, WO_MKV = WO_UKV + (size_t)1024 * 256,
                 WO_BM = WO_MKV + (size_t)1024 * 1024, WO_BD = WO_BM + (size_t)1024 * 512, WO_BE = WO_BD + (size_t)1024 * 1024, WO_OUT = WO_BE + (size_t)1024 * 512,
                 WO_1 = WO_OUT + (size_t)1024 * 1024, WO_2 = WO_1 + (size_t)4096 * 1024, WO_END = WO_2 + (size_t)4096 * 1024;
static_assert(WO_END * 2 <= 40 * MiB, "weight copies fit");

struct Params {
    const float *x, *mem; const int* pos;
    const float *w_in, *b_gate, *q_norm, *kv_norm, *w_uq, *w_ukv, *dlam, *subln, *w_mkv, *w_br, *w_out, *ln1g, *ln1b, *w1, *w2, *ln2g, *ln2b;
    float* out; unsigned char* ws;
};
typedef const __attribute__((address_space(4))) Params* kparams_t;
__device__ __forceinline__ kparams_t getp() { kparams_t kp = (kparams_t)__builtin_amdgcn_kernarg_segment_ptr(); asm volatile("" : "+s"(kp)); return kp; }

#define LDS_WAIT() asm volatile("s_waitcnt lgkmcnt(0)" ::: "memory")
__device__ __forceinline__ unsigned f2bf_u(float f) { unsigned u = __builtin_bit_cast(unsigned, f); return (u + 0x7fffu + ((u >> 16) & 1u)) >> 16; }
__device__ __forceinline__ unsigned pk2(float lo, float hi) { return f2bf_u(lo) | (f2bf_u(hi) << 16); }
__device__ __forceinline__ float wave_sum(float v) {
#pragma unroll
    for (int o = 1; o < 64; o <<= 1) v += __shfl_xor(v, o);
    return v;
}

__device__ __forceinline__ void tr_item(const float* W, int ldw, int sc, int K, bf16* WT, int n0, int k0, const float* gain, LAS float* scr, int lane) {
    float vv[32];
#pragma unroll
    for (int i = 0; i < 32; ++i) { const int kk = 2 * i + (lane >> 5); vv[i] = (sc >= 0) ? __builtin_nontemporal_load(W + (size_t)(k0 + kk) * ldw + sc + (lane & 31)) : 0.f; }
#pragma unroll
    for (int i = 0; i < 32; ++i) { const int kk = 2 * i + (lane >> 5); float v = vv[i]; if (sc >= 0 && gain) v *= gain[k0 + kk]; scr[kk * 33 + (lane & 31)] = v; }
    LDS_WAIT(); asm volatile("" ::: "memory");
    const int c = lane & 7;
#pragma unroll
    for (int j = 0; j < 4; ++j) { const int n = (lane >> 3) + 8 * j; const LAS float* s = scr + (8 * c) * 33 + n;
        v4u o; o.x = pk2(s[0 * 33], s[1 * 33]); o.y = pk2(s[2 * 33], s[3 * 33]); o.z = pk2(s[4 * 33], s[5 * 33]); o.w = pk2(s[6 * 33], s[7 * 33]);
        *(v4u*)(WT + (size_t)(n0 + n) * K + k0 + 8 * c) = o; }
    LDS_WAIT(); asm volatile("" ::: "memory");
}
__device__ __forceinline__ bool tr_job(int& it, const float* W, int ldw, int K, int N, bf16* WT, int kind, int coff, const float* gain, LAS float* scr, int lane) {
    const int nblk = N / 32, items = (K / 64) * nblk;
    if (it >= items) { it -= items; return false; }
    const int kb = it / nblk, nb = it % nblk, n0 = 32 * nb; int sc;
    if (kind == 0) sc = n0 + coff;
    else if (kind == 1) sc = (n0 < 672) ? n0 : (n0 < 768 ? -1 : n0 - 96);
    else sc = (n0 < 512) ? (n0 >> 6) * 96 + (n0 & 63) : ((n0 - 512) >> 5) * 96 + 64;
    tr_item(W, ldw, sc, K, WT, n0, 64 * kb, gain, scr, lane);
    return true;
}
__device__ __forceinline__ void convert_weights(int l, LAS unsigned char* lds, int gw, int NGW, int wave, int lane_) {
    int lane = lane_; asm volatile("" : "+v"(lane)); const kparams_t kp = getp();
    LAS float* scr = (LAS float*)(lds + wave * 16384);
    bf16* Wb = (bf16*)(kp->ws + WS_W);
    const float* w_in = kp->w_in + (size_t)l * DM * NIN; const float* wbr = kp->w_br + (size_t)l * 2048 * 1024;
    constexpr int NITEMS = 16 * 136 + 16 * 96 + 6 * 24 + 4 * 32 + 16 * 32 + 8 * 32 + 16 * 32 + 8 * 32 + 16 * 32 + 16 * 128 + 64 * 32;
    for (int item = gw; item < NITEMS; item += NGW) {
        int it = item;
        if (tr_job(it, w_in, NIN, 1024, 4352, Wb + WO_IN, 1, 0, nullptr, scr, lane)) continue;
        if (tr_job(it, w_in, NIN, 1024, 3072, Wb + WO_G, 0, 4256, nullptr, scr, lane)) continue;
        if (tr_job(it, kp->w_uq + (size_t)l * 384 * 768, 768, 384, 768, Wb + WO_UQ, 2, 0, kp->q_norm + l * 384, scr, lane)) continue;
        if (tr_job(it, kp->w_ukv + (size_t)l * 256 * 1024, 1024, 256, 1024, Wb + WO_UKV, 0, 0, kp->kv_norm + l * 256, scr, lane)) continue;
        if (tr_job(it, kp->w_mkv + (size_t)l * 1024 * 1024, 1024, 1024, 1024, Wb + WO_MKV, 0, 0, nullptr, scr, lane)) continue;
        if (tr_job(it, wbr, 1024, 512, 1024, Wb + WO_BM, 0, 0, nullptr, scr, lane)) continue;
        if (tr_job(it, wbr + (size_t)512 * 1024, 1024, 1024, 1024, Wb + WO_BD, 0, 0, nullptr, scr, lane)) continue;
        if (tr_job(it, wbr + (size_t)1536 * 1024, 1024, 512, 1024, Wb + WO_BE, 0, 0, nullptr, scr, lane)) continue;
        if (tr_job(it, kp->w_out + (size_t)l * 1024 * 1024, 1024, 1024, 1024, Wb + WO_OUT, 0, 0, nullptr, scr, lane)) continue;
        if (tr_job(it, kp->w1 + (size_t)l * 1024 * 4096, 4096, 1024, 4096, Wb + WO_1, 0, 0, nullptr, scr, lane)) continue;
        tr_job(it, kp->w2 + (size_t)l * 4096 * 1024, 1024, 4096, 1024, Wb + WO_2, 0, 0, nullptr, scr, lane);
    }
}
__device__ __forceinline__ void ln_rows(float* X, bf16* XB, const float* g, const float* b, int gw, int NGW, int lane_, int row_end = T) {
    int lane = lane_; asm volatile("" : "+v"(lane));
    f32x4 gv[4], bv[4];
#pragma unroll
    for (int j = 0; j < 4; ++j) { gv[j] = ((const f32x4*)g)[lane + 64 * j]; bv[j] = ((const f32x4*)b)[lane + 64 * j]; }
    for (int m = gw; m < row_end; m += 2 * NGW) {
        const int m2 = (m + NGW < row_end) ? m + NGW : m;
        f32x4* xr = (f32x4*)(X + (size_t)m * DM) + lane; f32x4* xr2 = (f32x4*)(X + (size_t)m2 * DM) + lane; f32x4 v[4], w[4]; float s = 0.f, t = 0.f;
#pragma unroll
        for (int j = 0; j < 4; ++j) { v[j] = xr[64 * j]; w[j] = xr2[64 * j]; }
#pragma unroll
        for (int j = 0; j < 4; ++j) { s += (v[j].x + v[j].y) + (v[j].z + v[j].w); t += (w[j].x + w[j].y) + (w[j].z + w[j].w); }
        const float mean = wave_sum(s) * (1.f / DM), mean2 = wave_sum(t) * (1.f / DM); float s2 = 0.f, t2 = 0.f;
#pragma unroll
        for (int j = 0; j < 4; ++j) { v[j] = v[j] - mean; s2 += (v[j].x * v[j].x + v[j].y * v[j].y) + (v[j].z * v[j].z + v[j].w * v[j].w);
                                      w[j] = w[j] - mean2; t2 += (w[j].x * w[j].x + w[j].y * w[j].y) + (w[j].z * w[j].z + w[j].w * w[j].w); }
        const float rstd = 1.f / sqrtf(wave_sum(s2) * (1.f / DM) + 1e-5f), rstd2 = 1.f / sqrtf(wave_sum(t2) * (1.f / DM) + 1e-5f);
        unsigned long long* o8 = (unsigned long long*)(XB + (size_t)m * DM) + lane; unsigned long long* o82 = (unsigned long long*)(XB + (size_t)m2 * DM) + lane;
#pragma unroll
        for (int j = 0; j < 4; ++j) { const f32x4 y = v[j] * rstd * gv[j] + bv[j]; xr[64 * j] = y;
            o8[64 * j] = (unsigned long long)pk2(y.x, y.y) | ((unsigned long long)pk2(y.z, y.w) << 32); }
        if (m2 != m) {
#pragma unroll
        for (int j = 0; j < 4; ++j) { const f32x4 y = w[j] * rstd2 * gv[j] + bv[j]; xr2[64 * j] = y;
            o82[64 * j] = (unsigned long long)pk2(y.x, y.y) | ((unsigned long long)pk2(y.z, y.w) << 32); } }
    }
}
__device__ __forceinline__ void rowscale_rows(const bf16* lat, float* rsq, float* rskv, int gw, int NGW, int lane_) {
    int lane = lane_; asm volatile("" : "+v"(lane));
    for (int row = gw; row < T; row += 4 * NGW) {
        unsigned w[4][5];
#pragma unroll
        for (int q = 0; q < 4; ++q) { const int rq = (row + q * NGW < T) ? row + q * NGW : row; const unsigned* src = (const unsigned*)(lat + (size_t)rq * 768) + lane;
#pragma unroll
            for (int k = 0; k < 5; ++k) w[q][k] = src[64 * k]; }
#pragma unroll
        for (int q = 0; q < 4; ++q) { float sq = 0.f, sk = 0.f;
#pragma unroll
            for (int k = 0; k < 5; ++k) { const float a = __uint_as_float(w[q][k] << 16), b = __uint_as_float(w[q][k] & 0xffff0000u); if (k < 3) sq += a * a + b * b; else sk += a * a + b * b; }
            sq = wave_sum(sq); sk = wave_sum(sk);
            if (lane == 0 && row + q * NGW < T) { rsq[row + q * NGW] = 1.0f / sqrtf(sq * (1.f / 384.f) + 1e-6f); rskv[row + q * NGW] = 1.0f / sqrtf(sk * (1.f / 256.f) + 1e-6f); } }
    }
}

#ifndef PH_MASK
#define PH_MASK 0xffff
#endif

#define WSP(T_, off) ((T_*)(ws + (off)))
#define XB_TMO      128
#define XB_XCNT(j)  (256  + 64 * (j))
#define XB_XSUB(j)  (1280 + 64 * (j))
#define XB_XGEN(j)  (2304 + 64 * (j))
#define XB_TOP      3328
#define XB_TOPGEN   3392
#define XCD_BAR_WORDS 3456
#define XB_SPIN_CAP (1u << 18)

__device__ __forceinline__ unsigned xb_ld(unsigned* p)              { return __hip_atomic_load(p, __ATOMIC_RELAXED, __HIP_MEMORY_SCOPE_AGENT); }
__device__ __forceinline__ unsigned xb_add(unsigned* p, unsigned v) { return __hip_atomic_fetch_add(p, v, __ATOMIC_RELAXED, __HIP_MEMORY_SCOPE_AGENT); }
__device__ __forceinline__ unsigned xb_xcc_id() { return (unsigned)__builtin_amdgcn_s_getreg((3 << 11) | 20) & 0xFu; }
#define XB_SPIN(cond, bar) do { unsigned _sp = 0; while (cond) { __builtin_amdgcn_s_sleep(1); \
    if ((++_sp & 255u) == 0u) { if (xb_ld(&(bar)[XB_TMO])) break; if (_sp > XB_SPIN_CAP) { atomicAdd(&(bar)[XB_TMO], 1u); break; } } } } while (0)

struct XcdBarrier {
    unsigned* bar; unsigned x;
    volatile LAS unsigned* st;
};

__device__ __forceinline__ XcdBarrier xcd_barrier_post(unsigned* bar, volatile LAS unsigned* st) {
    XcdBarrier b; b.bar = bar; b.x = xb_xcc_id(); b.st = st;
    if (threadIdx.x == 0) (void)xb_add(&bar[XB_XCNT(b.x)], 1u);
    return b;
}
__device__ __forceinline__ void xcd_barrier_complete(unsigned* bar, unsigned x, unsigned& nloc, unsigned& nx) {
    const unsigned G = gridDim.x * gridDim.y * gridDim.z;
    unsigned sum, cnt, mine, sp = 0u;
    for (;;) {
        sum = 0u; cnt = 0u; mine = 0u;
#pragma unroll
        for (unsigned j = 0; j < 16; ++j) { const unsigned c = xb_ld(&bar[XB_XCNT(j)]); sum += c; cnt += (c > 0u) ? 1u : 0u; mine = (j == x) ? c : mine; }
        if (sum == G) break;
        __builtin_amdgcn_s_sleep(1);
        if ((++sp & 255u) == 0u) { if (xb_ld(&bar[XB_TMO])) break; if (sp > XB_SPIN_CAP) { atomicAdd(&bar[XB_TMO], 1u); break; } }
    }
    nloc = mine > 0u ? mine : 1u; nx = cnt > 0u ? cnt : 1u;
}

__device__ __forceinline__ void xcd_barrier(const XcdBarrier& b) {
    asm volatile("s_waitcnt vmcnt(0)" ::: "memory");
    __syncthreads();
    if (threadIdx.x == 0) {
        unsigned* bar = b.bar;
        __builtin_amdgcn_s_waitcnt(0);
        unsigned nloc = b.st[0], nx = b.st[1];
        if (nloc == 0u) { xcd_barrier_complete(bar, b.x, nloc, nx); b.st[0] = nloc; b.st[1] = nx; }
        const unsigned old = xb_add(&bar[XB_XSUB(b.x)], 1u);
        const unsigned gen = old / nloc;
        if (old + 1u == (gen + 1u) * nloc) {
            __builtin_amdgcn_fence(__ATOMIC_RELEASE, "agent");
            asm volatile("s_waitcnt vmcnt(0)" ::: "memory");
            const unsigned og = xb_add(&bar[XB_TOP], 1u);
            const unsigned tg = og / nx;
            if (og + 1u == (tg + 1u) * nx) xb_add(&bar[XB_TOPGEN], 1u);
            else XB_SPIN(xb_ld(&bar[XB_TOPGEN]) == tg, bar);
            __builtin_amdgcn_fence(__ATOMIC_ACQUIRE, "agent");
            xb_add(&bar[XB_XGEN(b.x)], 1u);
            asm volatile("s_waitcnt vmcnt(0)" ::: "memory");
        } else {
            XB_SPIN(xb_ld(&bar[XB_XGEN(b.x)]) == gen, bar);
            __builtin_amdgcn_fence(__ATOMIC_ACQUIRE, "agent");
            asm volatile("s_waitcnt vmcnt(0)" ::: "memory");
        }
    }
    __syncthreads();
}

#define GRID_SYNC() do { XcdBarrier xb_; xb_.bar = (unsigned*)(getp()->ws + WS_BAR); xb_.x = xb_xcc_id(); xb_.st = (volatile LAS unsigned*)(lds + LDS_BYTES - 64); xcd_barrier(xb_); } while (0)
__global__ void __launch_bounds__(NTHREADS, 2) fwd_megakernel(Params p_unused) {
    extern __shared__ __attribute__((aligned(16))) unsigned char lds_raw[];
    cg::grid_group grid = cg::this_grid();
    LAS unsigned char* lds = (LAS unsigned char*)lds_raw;
    const int tid = threadIdx.x, lane = tid & 63, wave = __builtin_amdgcn_readfirstlane(tid >> 6);
    const int G = gridDim.x, bx = blockIdx.x;
    const int vcu = (G % 8 == 0) ? (bx % 8) * (G / 8) + bx / 8 : bx;
    const int gw = vcu * NWAVES + wave, NGW = G * NWAVES;
    volatile LAS unsigned* xst = (volatile LAS unsigned*)(lds + LDS_BYTES - 64);
    if (tid < 2) xst[tid] = 0u;
    __syncthreads();
    (void)xcd_barrier_post((unsigned*)(getp()->ws + WS_BAR), xst);
    grid.sync();

#if (PH_MASK & 1)
    {   const kparams_t kp = getp(); unsigned char* ws = kp->ws; float* X = kp->out; const float* xin = kp->x; const float* memin = kp->mem; const int* pos = kp->pos;
        bf16 *XB = WSP(bf16, WS_XB), *MEMB = WSP(bf16, WS_MEMB);
        float *COSM = WSP(float, WS_COSM), *SINM = WSP(float, WS_SINM), *COSD = WSP(float, WS_COSD), *SIND = WSP(float, WS_SIND);
        const long gt = (long)bx * NTHREADS + tid, NGT = (long)G * NTHREADS;
        for (long i = gt; i < (long)T * DM / 4; i += 4 * NGT) { f32x4 v[4];
#pragma unroll
            for (int q = 0; q < 4; ++q) v[q] = (i + q * NGT < (long)T * DM / 4) ? __builtin_nontemporal_load((const f32x4*)xin + i + q * NGT) : (f32x4){0.f, 0.f, 0.f, 0.f};
#pragma unroll
            for (int q = 0; q < 4; ++q) if (i + q * NGT < (long)T * DM / 4) { ((f32x4*)X)[i + q * NGT] = v[q];
                ((unsigned long long*)XB)[i + q * NGT] = (unsigned long long)pk2(v[q].x, v[q].y) | ((unsigned long long)pk2(v[q].z, v[q].w) << 32); } }
        for (long i = gt; i < (long)NBATCH * MEMLEN * DM / 4; i += NGT) { const f32x4 v = __builtin_nontemporal_load((const f32x4*)memin + i);
            ((unsigned long long*)MEMB)[i] = (unsigned long long)pk2(v.x, v.y) | ((unsigned long long)pk2(v.z, v.w) << 32); }
        for (long i = gt; i < (long)T * 16; i += NGT) { const int t = (int)(i >> 4), j = (int)(i & 15); const float inv = exp2f(-(float)(2 * j) * (18.931568569324174f / 32.f)); const float ang = (float)pos[t] * inv;
            const double a = (double)ang, n = rint(a * 0.15915494309189535), r = a - n * 6.283185307179586;
            COSM[i] = (float)cos(r); SINM[i] = (float)sin(r); }
        for (long i = gt; i < (long)T * 8; i += NGT) { const int t = (int)(i >> 3), j = (int)(i & 7); const float inv = exp2f(-(float)(2 * j) * (18.931568569324174f / 16.f)); const float ang = (float)pos[t] * inv;
            const double a = (double)ang, n = rint(a * 0.15915494309189535), r = a - n * 6.283185307179586;
            COSD[i] = (float)cos(r); SIND[i] = (float)sin(r); }
        convert_weights(0, lds, gw, NGW, wave, lane);
    }
    GRID_SYNC();
#endif

    for (int l = 0; l < DEPTH; ++l) {
        const float lambda_init = 0.8f - 0.6f * __expf(-0.3f * (float)l);
#if (PH_MASK & 2)
        {   const kparams_t kp = getp(); unsigned char* ws = kp->ws; bf16* Wb = WSP(bf16, WS_W);
            {   pg8::Gemm g{WSP(bf16, WS_XB), Wb + WO_IN, T, 4352, 1024, 1024, 1024}; pg8::StaticOrder S; S.init(T, 4352, G, bx);
                pg8::EpiH E{WSP(bf16, WS_LAT), WSP(bf16, WS_DQ), WSP(bf16, WS_DK), WSP(bf16, WS_DV), WSP(bf16, WS_MQ), WSP(float, WS_COSD), WSP(float, WS_SIND), WSP(float, WS_COSM), WSP(float, WS_SINM)};
                pg8::gemm_phase<pg8::EpiH, pg8::StaticOrder, true, true>(lds, g, S, E); }
            {   pg8::Gemm g{WSP(bf16, WS_MEMB), Wb + WO_MKV, NBATCH * MEMLEN, 1024, 1024, 1024, 1024}; pg8::StaticOrder S; S.init(NBATCH * MEMLEN, 1024, G, (bx + G / 2) % G);
                pg8::EpiScale<false> E{WSP(bf16, WS_MEMKV), 1024, nullptr, nullptr, nullptr};
                pg8::gemm_phase<pg8::EpiScale<false>, pg8::StaticOrder, true, true>(lds, g, S, E); } }
        GRID_SYNC();
#endif
#if (PH_MASK & 4)
        {   const kparams_t kp = getp(); unsigned char* ws = kp->ws; bf16* Wb = WSP(bf16, WS_W); bf16* LAT = WSP(bf16, WS_LAT); float *RSQ = WSP(float, WS_RSQ), *RSKV = WSP(float, WS_RSKV);
            rowscale_rows(LAT, RSQ, RSKV, gw, NGW, lane);
            GRID_SYNC();
            pg8::StaticOrder Sq; Sq.init(T, 768, G, bx); pg8::StaticOrder Skv; Skv.init(T, 1024, G, bx);
            {   pg8::Gemm g{LAT, Wb + WO_UQ, T, 768, 384, 768, 384}; pg8::EpiScale<true> E{WSP(bf16, WS_QM), 768, RSQ, WSP(float, WS_COSM), WSP(float, WS_SINM)};
                pg8::gemm_phase<pg8::EpiScale<true>, pg8::StaticOrder, true, true>(lds, g, Sq, E); }
            {   pg8::Gemm g{LAT + 384, Wb + WO_UKV, T, 1024, 256, 768, 256}; pg8::EpiScale<false> E{WSP(bf16, WS_KVM), 1024, RSKV, nullptr, nullptr};
                pg8::gemm_phase<pg8::EpiScale<false>, pg8::StaticOrder, true, true>(lds, g, Skv, E); } }
        GRID_SYNC();
#endif
        {
            const att::lptr alds = (att::lptr)lds;
            { const int rep = 1;
            int lane_a = lane; asm volatile("" : "+v"(lane_a)); const int r32 = lane_a & 31, hi = lane_a >> 5;
#if (PH_MASK & 8)
            {   const kparams_t kp = getp(); unsigned char* ws = kp->ws; bf16 *DQ = WSP(bf16, WS_DQ), *DK = WSP(bf16, WS_DK), *DV = WSP(bf16, WS_DV);
                float lam;
                {   const float* dl = kp->dlam + (size_t)l * 256; const float a = wave_sum(dl[lane_a] * dl[64 + lane_a]), b2 = wave_sum(dl[128 + lane_a] * dl[192 + lane_a]);
                    lam = __expf(a) - __expf(b2) + lambda_init; }
                const float* subln = kp->subln + l * 128;
                for (int idx = vcu; idx < NBATCH * 8 * 8; idx += G) {
                    const int bh = idx >> 3, qb = idx & 7, b = bh >> 3, h = bh & 7; const size_t row0 = (size_t)b * SEQ + qb * 256, key0 = (size_t)b * SEQ;
                    att::f32x16 o[4]; float rli[16];
                    att::Args A; A.ldq = 1024; A.ldk0 = 1024; A.ldk1 = 0; A.ldv = 1024; A.nkeys = SEQ; A.C = 0.125f * 1.4426950408889634f; A.thr = 8.f / 0.125f; A.Q1 = nullptr; A.K1 = nullptr;
                    A.Q0 = DQ + row0 * 1024 + h * 128; A.K0 = DK + key0 * 1024 + h * 128; A.V = DV + key0 * 1024 + h * 128;
                    att::attn_core<1>(A, alds, o, rli);
                    int ls = lane_a; asm volatile("" : "+v"(ls)); LAS unsigned* stash = (LAS unsigned*)(lds + att::STASH_OFF) + wave * 2048 + ls;
#pragma unroll
                    for (int d = 0; d < 4; ++d)
#pragma unroll
                        for (int j = 0; j < 8; ++j) stash[(d * 8 + j) * 64] = att::cvtpk(o[d][2 * j] * rli[2 * j], o[d][2 * j + 1] * rli[2 * j + 1]);
                    A.Q0 += 64; A.K0 += 64;
                    att::attn_core<1>(A, alds, o, rli);
                    float ss[16];
#pragma unroll
                    for (int r = 0; r < 16; ++r) ss[r] = 0.f;
#pragma unroll
                    for (int d = 0; d < 4; ++d)
#pragma unroll
                        for (int j = 0; j < 8; ++j) { const unsigned w = stash[(d * 8 + j) * 64];
                            const float d0v = __uint_as_float(w << 16) - lam * (o[d][2 * j] * rli[2 * j]), d1v = __uint_as_float(w & 0xffff0000u) - lam * (o[d][2 * j + 1] * rli[2 * j + 1]);
                            o[d][2 * j] = d0v; o[d][2 * j + 1] = d1v; ss[2 * j] += d0v * d0v; ss[2 * j + 1] += d1v * d1v; }
#pragma unroll
                    for (int r = 0; r < 16; ++r) { float s = ss[r]; s += __shfl_xor(s, 1); s += __shfl_xor(s, 2); s += __shfl_xor(s, 4); s += __shfl_xor(s, 8); s += __shfl_xor(s, 16);
                        ss[r] = (1.0f / sqrtf(s * (1.f / 128.f) + 1e-5f)) * (1.f - lambda_init); }
                    int lq = lane_a; asm volatile("" : "+v"(lq));
                    bf16* Ob = DQ + (row0 + wave * 32 + 4 * (lq >> 5)) * 1024 + h * 128 + (lq & 31);
#pragma unroll
                    for (int d = 0; d < 4; ++d) { const float gsub = subln[d * 32 + (lq & 31)];
#pragma unroll
                        for (int r = 0; r < 16; ++r) if (rep) Ob[att::crow(r, 0) * 1024 + d * 32] = att::f2bf(o[d][r] * ss[r] * gsub); }
                } }
#endif
#if (PH_MASK & 16)
            {   const kparams_t kp = getp(); unsigned char* ws = kp->ws; bf16 *QM = WSP(bf16, WS_QM), *KVM = WSP(bf16, WS_KVM), *LAT = WSP(bf16, WS_LAT);
                for (int idx = vcu; idx < NBATCH * 8 * 8; idx += G) {
                    const int bh = idx >> 3, qb = idx & 7, b = bh >> 3, h = bh & 7; const size_t row0 = (size_t)b * SEQ + qb * 256, key0 = (size_t)b * SEQ;
                    att::f32x16 o[2]; float rli[16];
                    att::Args A; A.ldq = 768; A.ldk0 = 1024; A.ldk1 = 768; A.ldv = 1024; A.nkeys = SEQ; A.C = 0.10206207261596575f * 1.4426950408889634f; A.thr = 8.f / 0.10206207261596575f;
                    A.Q0 = QM + row0 * 768 + h * 64; A.Q1 = QM + row0 * 768 + 512 + h * 32; A.K0 = KVM + key0 * 1024 + h * 128; A.K1 = LAT + key0 * 768 + 640; A.V = KVM + key0 * 1024 + h * 128 + 64;
                    att::attn_core<0>(A, alds, o, rli);
                    int lq = lane_a; asm volatile("" : "+v"(lq));
                    bf16* Ob = QM + (row0 + wave * 32 + 4 * (lq >> 5)) * 768 + h * 64 + (lq & 31);
#pragma unroll
                    for (int d = 0; d < 2; ++d)
#pragma unroll
                        for (int r = 0; r < 16; ++r) if (rep) Ob[att::crow(r, 0) * 768 + d * 32] = att::f2bf(o[d][r] * rli[r]);
                } }
#endif
#if (PH_MASK & 32)
            {   const kparams_t kp = getp(); unsigned char* ws = kp->ws; bf16 *MQ = WSP(bf16, WS_MQ), *MEMKV = WSP(bf16, WS_MEMKV);
                for (int idx = vcu; idx < NBATCH * 4 * 8; idx += G) {
                    const int bh = idx >> 3, qb = idx & 7, b = bh >> 2, h = bh & 3; const size_t row0 = (size_t)b * SEQ + qb * 256, key0 = (size_t)b * MEMLEN;
                    att::f32x16 o[4]; float rli[16];
                    att::Args A; A.ldq = 512; A.ldk0 = 1024; A.ldk1 = 0; A.ldv = 1024; A.nkeys = MEMLEN; A.C = 0.08838834764831845f * 1.4426950408889634f; A.thr = 8.f / 0.08838834764831845f; A.Q1 = nullptr; A.K1 = nullptr;
                    A.Q0 = MQ + row0 * 512 + h * 128; A.K0 = MEMKV + key0 * 1024 + h * 128; A.V = MEMKV + key0 * 1024 + 512 + h * 128;
                    att::attn_core<2>(A, alds, o, rli);
                    int lq = lane_a; asm volatile("" : "+v"(lq));
                    bf16* Ob = MQ + (row0 + wave * 32 + 4 * (lq >> 5)) * 512 + h * 128 + (lq & 31);
#pragma unroll
                    for (int d = 0; d < 4; ++d)
#pragma unroll
                        for (int r = 0; r < 16; ++r) if (rep) Ob[att::crow(r, 0) * 512 + d * 32] = att::f2bf(o[d][r] * rli[r]);
                } }
#endif
            }
        }
        GRID_SYNC();
#if (PH_MASK & 64)
        {   const kparams_t kp = getp(); unsigned char* ws = kp->ws; bf16* Wb = WSP(bf16, WS_W); bf16 *XB = WSP(bf16, WS_XB), *GB = WSP(bf16, WS_G), *MG = WSP(bf16, WS_MG);
            pg8::StaticOrder S; S.init(T, 1024, G, bx); const float* bg = kp->b_gate + (size_t)l * 3 * 1024;
            {
            {   pg8::Gemm g{XB, Wb + WO_G, T, 1024, 1024, 1024, 1024}; pg8::EpiGate E{GB, bg};
                pg8::gemm_phase<pg8::EpiGate, pg8::StaticOrder, true, true>(lds, g, S, E); }
            {   pg8::Gemm g{WSP(bf16, WS_QM), Wb + WO_BM, T, 1024, 512, 768, 512}; pg8::EpiBranch<true> E{GB, MG};
                pg8::gemm_phase<pg8::EpiBranch<true>, pg8::StaticOrder, true, true>(lds, g, S, E); }
            {   pg8::Gemm g{XB, Wb + WO_G + (size_t)1024 * 1024, T, 1024, 1024, 1024, 1024}; pg8::EpiGate E{GB, bg + 1024};
                pg8::gemm_phase<pg8::EpiGate, pg8::StaticOrder, true, true>(lds, g, S, E); }
            {   pg8::Gemm g{WSP(bf16, WS_DQ), Wb + WO_BD, T, 1024, 1024, 1024, 1024}; pg8::EpiBranch<false> E{GB, MG};
                pg8::gemm_phase<pg8::EpiBranch<false>, pg8::StaticOrder, true, true>(lds, g, S, E); }
            {   pg8::Gemm g{XB, Wb + WO_G + (size_t)2048 * 1024, T, 1024, 1024, 1024, 1024}; pg8::EpiGate E{GB, bg + 2048};
                pg8::gemm_phase<pg8::EpiGate, pg8::StaticOrder, true, true>(lds, g, S, E); }
            {   pg8::Gemm g{WSP(bf16, WS_MQ), Wb + WO_BE, T, 1024, 512, 512, 512}; pg8::EpiBranch<false> E{GB, MG};
                pg8::gemm_phase<pg8::EpiBranch<false>, pg8::StaticOrder, true, true>(lds, g, S, E); } } }
        GRID_SYNC();
#endif
#if (PH_MASK & 128)
        {   const kparams_t kp = getp(); unsigned char* ws = kp->ws;
            pg8::Gemm g{WSP(bf16, WS_MG), WSP(bf16, WS_W) + WO_OUT, T, 1024, 1024, 1024, 1024}; pg8::StaticOrder S; S.init(T, 1024, G, bx); pg8::EpiRes E{kp->out, ALPHA};
            pg8::gemm_phase<pg8::EpiRes, pg8::StaticOrder, true, true>(lds, g, S, E); }
        GRID_SYNC();
#endif
        {   const kparams_t kp = getp(); unsigned char* ws = kp->ws;
            ln_rows(kp->out, WSP(bf16, WS_XB), kp->ln1g + l * DM, kp->ln1b + l * DM, gw, NGW, lane); }
        GRID_SYNC();
#if (PH_MASK & 256)
        {   const kparams_t kp = getp(); unsigned char* ws = kp->ws;
            pg8::Gemm g{WSP(bf16, WS_XB), WSP(bf16, WS_W) + WO_1, T, 4096, 1024, 1024, 1024}; pg8::StaticOrder S; S.init(T, 4096, G, bx); pg8::EpiRelu2 E{WSP(bf16, WS_HID), 4096};
            pg8::gemm_phase<pg8::EpiRelu2, pg8::StaticOrder, true, true>(lds, g, S, E); }
        GRID_SYNC();
#endif
#if (PH_MASK & 512)
        {   const kparams_t kp = getp(); unsigned char* ws = kp->ws;
            pg8::Gemm g{WSP(bf16, WS_HID), WSP(bf16, WS_W) + WO_2, T, 1024, 4096, 4096, 4096}; pg8::StaticOrder S; S.init(T, 1024, G, bx); pg8::EpiRes E{kp->out, ALPHA};
            pg8::gemm_phase<pg8::EpiRes, pg8::StaticOrder, true, true>(lds, g, S, E); }
        GRID_SYNC();
#endif
        {   const kparams_t kp = getp(); unsigned char* ws = kp->ws;
            ln_rows(kp->out, WSP(bf16, WS_XB), kp->ln2g + l * DM, kp->ln2b + l * DM, gw, NGW, lane); }
        if (l + 1 < DEPTH) { convert_weights(l + 1, lds, gw, NGW, wave, lane); GRID_SYNC(); }
    }
}

extern "C" void kernel_launch(void* const* d_in, const int* in_sizes, int n_in, void* d_out, int out_size, void* d_ws, size_t ws_size, hipStream_t stream) {
    static int grid = 0;
    if (grid == 0) {
        if (n_in != 20 || in_sizes[0] != T * DM || out_size != T * DM || ws_size < WS_END) {
            fprintf(stderr, "kernel_launch: unexpected shapes (n_in %d, in0 %d, out %d, ws %zu; need ws >= %zu); nothing launched\n", n_in, n_in > 0 ? in_sizes[0] : -1, out_size, ws_size, (size_t)WS_END); grid = -1; return; }
        int dev = 0, cus = 0, per_cu = 0;
        if (hipGetDevice(&dev) != hipSuccess || hipDeviceGetAttribute(&cus, hipDeviceAttributeMultiprocessorCount, dev) != hipSuccess) { grid = -1; return; }
        if (hipFuncSetAttribute((const void*)fwd_megakernel, hipFuncAttributeMaxDynamicSharedMemorySize, LDS_BYTES) != hipSuccess) { fprintf(stderr, "kernel_launch: hipFuncSetAttribute failed\n"); grid = -1; return; }
        if (hipOccupancyMaxActiveBlocksPerMultiprocessor(&per_cu, (const void*)fwd_megakernel, NTHREADS, LDS_BYTES) != hipSuccess || per_cu < 1) { fprintf(stderr, "kernel_launch: occupancy query says %d\n", per_cu); per_cu = 1; }
        (void)hipGetLastError();
        grid = cus * 1;
    }
    if (grid < 0) return;
    if (hipMemsetAsync((char*)d_ws + WS_BAR, 0, 16384, stream) != hipSuccess) { fprintf(stderr, "kernel_launch: hipMemsetAsync failed\n"); return; }
    Params p{};
    p.x = (const float*)d_in[0]; p.mem = (const float*)d_in[1]; p.pos = (const int*)d_in[2];
    p.w_in = (const float*)d_in[3]; p.b_gate = (const float*)d_in[4]; p.q_norm = (const float*)d_in[5]; p.kv_norm = (const float*)d_in[6];
    p.w_uq = (const float*)d_in[7]; p.w_ukv = (const float*)d_in[8]; p.dlam = (const float*)d_in[9]; p.subln = (const float*)d_in[10];
    p.w_mkv = (const float*)d_in[11]; p.w_br = (const float*)d_in[12]; p.w_out = (const float*)d_in[13]; p.ln1g = (const float*)d_in[14]; p.ln1b = (const float*)d_in[15];
    p.w1 = (const float*)d_in[16]; p.w2 = (const float*)d_in[17]; p.ln2g = (const float*)d_in[18]; p.ln2b = (const float*)d_in[19];
    p.out = (float*)d_out; p.ws = (unsigned char*)d_ws;
    void* args[] = {&p};
    hipError_t e = hipLaunchCooperativeKernel((const void*)fwd_megakernel, dim3(grid), dim3(NTHREADS), args, LDS_BYTES, stream);
    if (e != hipSuccess) fprintf(stderr, "kernel_launch: cooperative launch failed: %s (grid %d)\n", hipGetErrorString(e), grid);
}
```

```cpp
#include <hip/hip_runtime.h>
#include <hip/hip_cooperative_groups.h>
#include <cstdio>
#include <cstdint>
#include <cmath>
namespace cg = cooperative_groups;

namespace pg8 {
#define PG8_LAS __attribute__((address_space(3)))
typedef unsigned short bf16_t;
typedef short bf16x8 __attribute__((ext_vector_type(8)));
typedef float f32x4 __attribute__((ext_vector_type(4)));
typedef unsigned u32x4 __attribute__((ext_vector_type(4)));
constexpr int BM = 256, BK = 64, HALF = 128, HTB = HALF * BK * 2  , STAGE_BYTES = 8 * HTB, NXCD = 8, WGM = 8;

__host__ __device__ __forceinline__ int lds_byte(int r, int c) { const int st = (r >> 4) * 2 + (c >> 5), rr = r & 15, cc = c & 31, ob = rr * 64 + cc * 2; return st * 1024 + (ob ^ (((ob >> 9) & 1) << 5)); }
__host__ __device__ __forceinline__ void stage_rc(int b, int& R, int& C) { const int st = b / 1024, sb = b % 1024, swz = sb ^ (((sb >> 9) & 1) << 5); R = (st >> 1) * 16 + swz / 64; C = (st & 1) * 32 + (swz % 64) / 2; }
__host__ __device__ __forceinline__ int perm32(int rho) { const int n = rho >> 4, i = rho & 15; return 8 * (i >> 2) + 4 * n + (i & 3); }

struct Unit { int pm, pn; };
struct Gemm { const bf16_t* A; const bf16_t* Bt; int M, N, K, lda, ldb; };

struct StaticOrder {
    int nM, nN, nwg, G, c;
    __host__ __device__ void init(int M, int N, int G_, int c_) { nM = M / BM; nN = N / BM; nwg = nM * nN; G = G_; c = c_; }
    __host__ __device__ bool next(int i, Unit& u) const {
        const long L = (long)i * G + c; if (L >= nwg) return false;
        int wgid = (int)L; { const int q = nwg / NXCD, r = nwg % NXCD, xcd = wgid % NXCD, off = wgid / NXCD; wgid = (xcd < r ? xcd * (q + 1) : r * (q + 1) + (xcd - r) * q) + off; }
        const int nig = WGM * nN, gid = wgid / nig, fm = gid * WGM, gsz = (nM - fm) < WGM ? (nM - fm) : WGM;
        u.pm = fm + ((wgid % nig) % gsz); u.pn = (wgid % nig) / gsz; return true;
    }
    __device__ __forceinline__ void a_ready(const Unit&) const {}
    __device__ __forceinline__ void done(const Unit&) const {}
};

__device__ __forceinline__ unsigned cvt_pk_bf16(float lo, float hi) { unsigned r; asm volatile("v_cvt_pk_bf16_f32 %0, %1, %2" : "=v"(r) : "v"(lo), "v"(hi)); return r; }
__device__ __forceinline__ u32x4 pack8(const f32x4 v0, const f32x4 v1) { u32x4 w; w.x = cvt_pk_bf16(v0[0], v0[1]); w.y = cvt_pk_bf16(v0[2], v0[3]); w.z = cvt_pk_bf16(v1[0], v1[1]); w.w = cvt_pk_bf16(v1[2], v1[3]); return w; }
__device__ __forceinline__ u32x4 ld16_l2(const bf16_t* p) { const unsigned long long* q = (const unsigned long long*)p; const unsigned long long a = __hip_atomic_load(q, __ATOMIC_RELAXED, __HIP_MEMORY_SCOPE_AGENT), b = __hip_atomic_load(q + 1, __ATOMIC_RELAXED, __HIP_MEMORY_SCOPE_AGENT);
    u32x4 r; r.x = (unsigned)a; r.y = (unsigned)(a >> 32); r.z = (unsigned)b; r.w = (unsigned)(b >> 32); return r; }
__device__ __forceinline__ void st16(void* p, const u32x4 w) { unsigned long long* q = (unsigned long long*)p;
    __hip_atomic_store(q, (unsigned long long)w.x | ((unsigned long long)w.y << 32), __ATOMIC_RELAXED, __HIP_MEMORY_SCOPE_SYSTEM);
    __hip_atomic_store(q + 1, (unsigned long long)w.z | ((unsigned long long)w.w << 32), __ATOMIC_RELAXED, __HIP_MEMORY_SCOPE_SYSTEM); }
__device__ __forceinline__ float sgm(float v) { return __builtin_amdgcn_rcpf(1.f + __expf(-v)); }
__device__ __forceinline__ float bflo(unsigned w) { return __uint_as_float(w << 16); }
__device__ __forceinline__ float bfhi(unsigned w) { return __uint_as_float(w & 0xffff0000u); }
__device__ __forceinline__ f32x4 shx4(const f32x4 v, int m) { f32x4 r; r[0] = __shfl_xor(v[0], m); r[1] = __shfl_xor(v[1], m); r[2] = __shfl_xor(v[2], m); r[3] = __shfl_xor(v[3], m); return r; }

struct EpiH {
    static constexpr bool PERM = true, AFTER_DRAIN = false;
    bf16_t *lat, *dq, *dk, *dv, *mq; const float *cosd, *sind, *cosm, *sinm;
    __device__ __forceinline__ void operator()(const f32x4 (&acc)[2][2][4][2], const Unit& u, int wr, int wc, int fr, int fq) const {
        const int pn = u.pn; bf16_t* base; int ld, c0, mode;
        if (pn < 3) { base = lat; ld = 768; c0 = pn * 256; mode = (pn == 2) ? 2 : 0; }
        else if (pn < 7) { base = dq; ld = 1024; c0 = (pn - 3) * 256; mode = 1; }
        else if (pn < 11) { base = dk; ld = 1024; c0 = (pn - 7) * 256; mode = 1; }
        else if (pn < 15) { base = dv; ld = 1024; c0 = (pn - 11) * 256; mode = 0; }
        else { base = mq; ld = 512; c0 = (pn - 15) * 256; mode = 0; }
        const int row0 = u.pm * BM + wr * 64 + fr, colw = c0 + wc * 32 + 8 * fq;
#pragma unroll
        for (int ai = 0; ai < 2; ++ai)
#pragma unroll
            for (int m = 0; m < 4; ++m) { const int row = row0 + ai * HALF + m * 16; bf16_t* rowp = base + (size_t)row * ld + colw;
#pragma unroll
                for (int bj = 0; bj < 2; ++bj) { f32x4 v0 = acc[ai][bj][m][0], v1 = acc[ai][bj][m][1];
                    if (mode == 1 && (wc & 1) == 0) {
                        const f32x4 p0 = shx4(v0, 16), p1 = shx4(v1, 16);
                        if (fq < 2) { const f32x4 c0v = *(const f32x4*)(cosd + (size_t)row * 8), c1v = *(const f32x4*)(cosd + (size_t)row * 8 + 4);
                            f32x4 s0v = *(const f32x4*)(sind + (size_t)row * 8), s1v = *(const f32x4*)(sind + (size_t)row * 8 + 4);
                            if (fq == 0) { s0v = -s0v; s1v = -s1v; }
                            v0 = v0 * c0v + p0 * s0v; v1 = v1 * c1v + p1 * s1v; } }
                    if (mode == 2 && bj == 1 && wc == 0) {
                        const f32x4 p0 = shx4(v0, 32), p1 = shx4(v1, 32); const int i16 = (fq & 1) * 8;
                        const f32x4 c0v = *(const f32x4*)(cosm + (size_t)row * 16 + i16), c1v = *(const f32x4*)(cosm + (size_t)row * 16 + i16 + 4);
                        f32x4 s0v = *(const f32x4*)(sinm + (size_t)row * 16 + i16), s1v = *(const f32x4*)(sinm + (size_t)row * 16 + i16 + 4);
                        if (fq < 2) { s0v = -s0v; s1v = -s1v; }
                        v0 = v0 * c0v + p0 * s0v; v1 = v1 * c1v + p1 * s1v; }
                    *(u32x4*)(rowp + bj * HALF) = pack8(v0, v1); }
                asm volatile("" ::: "memory"); }
    }
};
template <bool ROPE> struct EpiScale {
    static constexpr bool PERM = true, AFTER_DRAIN = false;
    bf16_t* O; int ld; const float* rs; const float *cosm, *sinm;
    __device__ __forceinline__ void operator()(const f32x4 (&acc)[2][2][4][2], const Unit& u, int wr, int wc, int fr, int fq) const {
        const int row0 = u.pm * BM + wr * 64 + fr, colw = u.pn * BM + wc * 32 + 8 * fq;
#pragma unroll
        for (int ai = 0; ai < 2; ++ai)
#pragma unroll
            for (int m = 0; m < 4; ++m) { const int row = row0 + ai * HALF + m * 16; bf16_t* rowp = O + (size_t)row * ld + colw;
                const float sc = rs ? __hip_atomic_load(rs + row, __ATOMIC_RELAXED, __HIP_MEMORY_SCOPE_AGENT) : 1.f;
#pragma unroll
                for (int bj = 0; bj < 2; ++bj) { f32x4 v0 = acc[ai][bj][m][0] * sc, v1 = acc[ai][bj][m][1] * sc;
                    if (ROPE && u.pn == 2) {
                        const f32x4 p0 = shx4(v0, 32), p1 = shx4(v1, 32); const int i16 = (fq & 1) * 8;
                        const f32x4 c0v = *(const f32x4*)(cosm + (size_t)row * 16 + i16), c1v = *(const f32x4*)(cosm + (size_t)row * 16 + i16 + 4);
                        f32x4 s0v = *(const f32x4*)(sinm + (size_t)row * 16 + i16), s1v = *(const f32x4*)(sinm + (size_t)row * 16 + i16 + 4);
                        if (fq < 2) { s0v = -s0v; s1v = -s1v; }
                        v0 = v0 * c0v + p0 * s0v; v1 = v1 * c1v + p1 * s1v; }
                    *(u32x4*)(rowp + bj * HALF) = pack8(v0, v1); }
                asm volatile("" ::: "memory"); }
    }
};
struct EpiGate {
    static constexpr bool PERM = true, AFTER_DRAIN = false;
    bf16_t* G; const float* bias;
    __device__ __forceinline__ void operator()(const f32x4 (&acc)[2][2][4][2], const Unit& u, int wr, int wc, int fr, int fq) const {
        const int row0 = u.pm * BM + wr * 64 + fr, colw = u.pn * BM + wc * 32 + 8 * fq;
        f32x4 bv[2][2];
#pragma unroll
        for (int bj = 0; bj < 2; ++bj)
#pragma unroll
            for (int n = 0; n < 2; ++n) bv[bj][n] = *(const f32x4*)(bias + colw + bj * HALF + 4 * n);
#pragma unroll
        for (int ai = 0; ai < 2; ++ai)
#pragma unroll
            for (int m = 0; m < 4; ++m) { bf16_t* rowp = G + (size_t)(row0 + ai * HALF + m * 16) * 1024 + colw;
#pragma unroll
                for (int bj = 0; bj < 2; ++bj) { f32x4 v0 = acc[ai][bj][m][0] + bv[bj][0], v1 = acc[ai][bj][m][1] + bv[bj][1];
                    *(u32x4*)(rowp + bj * HALF) = pack8(v0, v1); }
                asm volatile("" ::: "memory"); }
    }
};
template <bool FIRST> struct EpiBranch {
    static constexpr bool PERM = true, AFTER_DRAIN = false;
    const bf16_t* G; bf16_t* Mg;
    __device__ __forceinline__ void operator()(const f32x4 (&acc)[2][2][4][2], const Unit& u, int wr, int wc, int fr, int fq) const {
        const int row0 = u.pm * BM + wr * 64 + fr, colw = u.pn * BM + wc * 32 + 8 * fq;
#pragma unroll
        for (int ai = 0; ai < 2; ++ai)
#pragma unroll
            for (int m = 0; m < 4; ++m) { const size_t off = (size_t)(row0 + ai * HALF + m * 16) * 1024 + colw;
#pragma unroll
                for (int bj = 0; bj < 2; ++bj) { const u32x4 g = *(const u32x4*)(G + off + bj * HALF);
                    f32x4 v0 = acc[ai][bj][m][0], v1 = acc[ai][bj][m][1];
                    v0[0] *= sgm(bflo(g.x)); v0[1] *= sgm(bfhi(g.x)); v0[2] *= sgm(bflo(g.y)); v0[3] *= sgm(bfhi(g.y)); v1[0] *= sgm(bflo(g.z)); v1[1] *= sgm(bfhi(g.z)); v1[2] *= sgm(bflo(g.w)); v1[3] *= sgm(bfhi(g.w));
                    if (!FIRST) { const u32x4 o = *(const u32x4*)(Mg + off + bj * HALF);
                        v0[0] += bflo(o.x); v0[1] += bfhi(o.x); v0[2] += bflo(o.y); v0[3] += bfhi(o.y); v1[0] += bflo(o.z); v1[1] += bfhi(o.z); v1[2] += bflo(o.w); v1[3] += bfhi(o.w); }
                    *(u32x4*)(Mg + off + bj * HALF) = pack8(v0, v1); }
                asm volatile("" ::: "memory"); }
    }
};
struct EpiRes {
    static constexpr bool PERM = false, AFTER_DRAIN = false;
    float* X; float alpha;
    __device__ __forceinline__ void operator()(const f32x4 (&acc)[2][2][4][2], const Unit& u, int wr, int wc, int fr, int fq) const {
        const int row0 = u.pm * BM + wr * 64 + fr, col0 = u.pn * BM + wc * 32 + 4 * fq;
        float* base = X + (size_t)row0 * 1024 + col0;
        f32x4 xq[2][2][2];
#pragma unroll
        for (int bj = 0; bj < 2; ++bj)
#pragma unroll
            for (int n = 0; n < 2; ++n) xq[0][bj][n] = *(const f32x4*)(base + bj * HALF + n * 16);
#pragma unroll
        for (int it = 0; it < 8; ++it) { const int ai = it >> 2, m = it & 3, cur = it & 1; float* rowp = base + (size_t)(ai * HALF + m * 16) * 1024;
            if (it < 7) { const float* rown = base + (size_t)(((it + 1) >> 2) * HALF + ((it + 1) & 3) * 16) * 1024;
#pragma unroll
                for (int bj = 0; bj < 2; ++bj)
#pragma unroll
                    for (int n = 0; n < 2; ++n) xq[cur ^ 1][bj][n] = *(const f32x4*)(rown + bj * HALF + n * 16); }
#pragma unroll
            for (int bj = 0; bj < 2; ++bj)
#pragma unroll
                for (int n = 0; n < 2; ++n) *(f32x4*)(rowp + bj * HALF + n * 16) = xq[cur][bj][n] * alpha + acc[ai][bj][m][n];
            asm volatile("" ::: "memory"); }
    }
};
struct EpiRelu2 {
    static constexpr bool PERM = true, AFTER_DRAIN = false;
    bf16_t* H; int ld;
    __device__ __forceinline__ void operator()(const f32x4 (&acc)[2][2][4][2], const Unit& u, int wr, int wc, int fr, int fq) const {
        const int row0 = u.pm * BM + wr * 64 + fr, colw = u.pn * BM + wc * 32 + 8 * fq;
#pragma unroll
        for (int ai = 0; ai < 2; ++ai)
#pragma unroll
            for (int m = 0; m < 4; ++m) { bf16_t* rowp = H + (size_t)(row0 + ai * HALF + m * 16) * ld + colw;
#pragma unroll
                for (int bj = 0; bj < 2; ++bj) { f32x4 v0 = acc[ai][bj][m][0], v1 = acc[ai][bj][m][1];
#pragma unroll
                    for (int e = 0; e < 4; ++e) { const float a = fmaxf(v0[e], 0.f), b = fmaxf(v1[e], 0.f); v0[e] = a * a; v1[e] = b * b; }
                    *(u32x4*)(rowp + bj * HALF) = pack8(v0, v1); }
                asm volatile("" ::: "memory"); }
    }
};

template <class Epi, class Sched, bool ALIGN_EPI = false, bool SP2 = false>
__device__ __forceinline__ void gemm_phase(PG8_LAS unsigned char* lds, const Gemm g, const Sched& S, const Epi& E) {
    int tid_ = threadIdx.x; asm volatile("" : "+v"(tid_));
    const int tid = tid_, wid = __builtin_amdgcn_readfirstlane(tid >> 6), lane = tid & 63, wr = wid >> 2, wc = wid & 3, fr = lane & 15, fq = lane >> 4;
    int K_ = g.K; asm volatile("" : "+s"(K_));
    const int K = K_, nt = K / BK;
    unsigned voffA[2], voffB[2];
#pragma unroll
    for (int i = 0; i < 2; ++i) { int R, C; stage_rc(tid * 16 + i * 8192, R, C); const int Rb = Epi::PERM ? ((R & ~31) + perm32(R & 31)) : R;
        voffA[i] = (unsigned)(R * g.lda + C) * 2u; voffB[i] = (unsigned)(Rb * g.ldb + C) * 2u; }
    const size_t kstep = (size_t)(BK * 2);
    const size_t hstepA = (size_t)HALF * g.lda * 2, hstepB = (size_t)HALF * g.ldb * 2;
    const size_t tstepA = 2 * hstepA, tstepB = 2 * hstepB;
    const unsigned ldsw = (unsigned)wid * 1024u;
    const int aoff = lds_byte(wr * 64 + fr, fq * 8), boff = lds_byte(wc * 32 + fr, fq * 8);
#define PG8_SA(b, h) (((b) * 2 + (h)) * HTB)
#define PG8_SB(b, h) ((4 + (b) * 2 + (h)) * HTB)
#define PG8_STAGE(bufoff, gbase, voff) do { _Pragma("unroll") for (int _i = 0; _i < 2; ++_i) \
        __builtin_amdgcn_global_load_lds((const unsigned*)((const char*)(gbase) + (voff)[_i]), (PG8_LAS unsigned*)(lds + (bufoff) + ldsw + _i * 8192), 16, 0, 0); } while (0)
#define PG8_LDA(dst, b, h) do { _Pragma("unroll") for (int m = 0; m < 4; ++m) _Pragma("unroll") for (int k = 0; k < 2; ++k) dst[m][k] = *(const PG8_LAS bf16x8*)(lds + PG8_SA(b, h) + aoff + m * 2048 + k * 1024); } while (0)
#define PG8_LDB(dst, b, h) do { _Pragma("unroll") for (int n = 0; n < 2; ++n) _Pragma("unroll") for (int k = 0; k < 2; ++k) dst[n][k] = *(const PG8_LAS bf16x8*)(lds + PG8_SB(b, h) + boff + n * 2048 + k * 1024); } while (0)
#define PG8_MMA(ai, bj, At, Bt) do { __builtin_amdgcn_s_setprio(1); _Pragma("unroll") for (int m = 0; m < 4; ++m) _Pragma("unroll") for (int n = 0; n < 2; ++n) _Pragma("unroll") for (int k = 0; k < 2; ++k) \
        acc[ai][bj][m][n] = __builtin_amdgcn_mfma_f32_16x16x32_bf16(Bt[n][k], At[m][k], acc[ai][bj][m][n], 0, 0, 0); __builtin_amdgcn_s_setprio(0); } while (0)
#define PG8_WAIT_V(n) asm volatile("s_waitcnt vmcnt(" #n ")" ::: "memory")
#define PG8_WAIT_L(n) asm volatile("s_waitcnt lgkmcnt(" #n ")" ::: "memory")
#define PG8_BAR __builtin_amdgcn_s_barrier()
#define PG8_SCHED __builtin_amdgcn_sched_barrier(0)
    Unit cur, nxt; int ui = 0;
    if (!S.next(0, cur)) return;
    f32x4 acc[2][2][4][2];
#pragma unroll
    for (int a = 0; a < 2; ++a)
#pragma unroll
        for (int b = 0; b < 2; ++b)
#pragma unroll
            for (int m = 0; m < 4; ++m)
#pragma unroll
                for (int n = 0; n < 2; ++n) acc[a][b][m][n] = (f32x4){0.f, 0.f, 0.f, 0.f};
    bf16x8 At[4][2], B0[2][2], B1[2][2];
    const char* cA = (const char*)g.A + (size_t)cur.pm * tstepA; const char* cB = (const char*)g.Bt + (size_t)cur.pn * tstepB;
    S.a_ready(cur);
    if constexpr (SP2) {
        PG8_STAGE(PG8_SB(0, 0), cB, voffB); PG8_STAGE(PG8_SB(0, 1), cB + hstepB, voffB); PG8_STAGE(PG8_SA(0, 0), cA, voffA); PG8_STAGE(PG8_SA(0, 1), cA + hstepA, voffA);
        if (wr == 1) PG8_BAR;
        PG8_WAIT_V(2); PG8_BAR;
        PG8_STAGE(PG8_SB(1, 0), cB + kstep, voffB); PG8_STAGE(PG8_SA(1, 0), cA + kstep, voffA); PG8_STAGE(PG8_SB(1, 1), cB + hstepB + kstep, voffB);
        PG8_WAIT_V(6); PG8_BAR;
    } else {
        PG8_STAGE(PG8_SB(0, 0), cB, voffB); PG8_STAGE(PG8_SA(0, 0), cA, voffA); PG8_STAGE(PG8_SB(0, 1), cB + hstepB, voffB); PG8_STAGE(PG8_SA(0, 1), cA + hstepA, voffA);
        if (wr == 1) PG8_BAR;
        PG8_WAIT_V(4); PG8_BAR;
        PG8_STAGE(PG8_SB(1, 0), cB + kstep, voffB); PG8_STAGE(PG8_SA(1, 0), cA + kstep, voffA); PG8_STAGE(PG8_SB(1, 1), cB + hstepB + kstep, voffB);
        PG8_WAIT_V(6); PG8_BAR;
    }
    for (;;) {
        const bool has_next = S.next(ui + 1, nxt);
        const char* nA = has_next ? (const char*)g.A + (size_t)nxt.pm * tstepA : cA; const char* nB = has_next ? (const char*)g.Bt + (size_t)nxt.pn * tstepB : cB;
        for (int t = 0; t < nt; t += 2) {
            const bool last = (t == nt - 2);
            const char* a1 = cA + (size_t)(t + 1) * kstep;
            const char* a2 = last ? nA : cA + (size_t)(t + 2) * kstep; const char* b2 = last ? nB : cB + (size_t)(t + 2) * kstep;
            const char* a3 = a2 + kstep; const char* b3 = b2 + kstep;
            if (last && has_next) S.a_ready(nxt);
            if constexpr (SP2) {
            PG8_LDB(B0, 0, 0); PG8_LDB(B1, 0, 1); PG8_SCHED; PG8_LDA(At, 0, 0); PG8_STAGE(PG8_SA(1, 1), a1 + hstepA, voffA);
            PG8_WAIT_V(8); PG8_WAIT_L(0); PG8_BAR; PG8_MMA(0, 0, At, B0); PG8_MMA(0, 1, At, B1); PG8_BAR; PG8_SCHED;
            PG8_LDA(At, 0, 1); PG8_STAGE(PG8_SB(0, 0), b2, voffB); PG8_STAGE(PG8_SB(0, 1), b2 + hstepB, voffB); PG8_STAGE(PG8_SA(0, 0), a2, voffA);
            PG8_WAIT_V(8); PG8_WAIT_L(0); PG8_BAR; PG8_MMA(1, 0, At, B0); PG8_MMA(1, 1, At, B1); PG8_BAR; PG8_SCHED;
            PG8_LDB(B0, 1, 0); PG8_LDB(B1, 1, 1); PG8_SCHED; PG8_LDA(At, 1, 0); PG8_STAGE(PG8_SA(0, 1), a2 + hstepA, voffA);
            PG8_WAIT_V(8); PG8_WAIT_L(0); PG8_BAR; PG8_MMA(0, 0, At, B0); PG8_MMA(0, 1, At, B1); PG8_BAR; PG8_SCHED;
            PG8_LDA(At, 1, 1); PG8_STAGE(PG8_SB(1, 0), b3, voffB); PG8_STAGE(PG8_SB(1, 1), b3 + hstepB, voffB); PG8_STAGE(PG8_SA(1, 0), a3, voffA);
            PG8_WAIT_V(8); PG8_WAIT_L(0); PG8_BAR; PG8_MMA(1, 0, At, B0); PG8_MMA(1, 1, At, B1); PG8_BAR; PG8_SCHED;
            } else {
            PG8_LDB(B0, 0, 0); PG8_SCHED; PG8_LDA(At, 0, 0); PG8_STAGE(PG8_SA(1, 1), a1 + hstepA, voffA);
            PG8_WAIT_L(8); PG8_BAR; PG8_WAIT_L(0); PG8_MMA(0, 0, At, B0); PG8_BAR; PG8_SCHED;
            PG8_LDB(B1, 0, 1); PG8_STAGE(PG8_SB(0, 0), b2, voffB);
            PG8_BAR; PG8_WAIT_L(0); PG8_MMA(0, 1, At, B1); PG8_BAR;
            PG8_LDA(At, 0, 1); PG8_STAGE(PG8_SA(0, 0), a2, voffA);
            PG8_BAR; PG8_WAIT_L(0); PG8_MMA(1, 0, At, B0); PG8_BAR; PG8_SCHED;
            PG8_STAGE(PG8_SB(0, 1), b2 + hstepB, voffB);
            PG8_WAIT_V(6); PG8_BAR; PG8_MMA(1, 1, At, B1); PG8_BAR;
            PG8_LDB(B0, 1, 0); PG8_SCHED; PG8_LDA(At, 1, 0); PG8_STAGE(PG8_SA(0, 1), a2 + hstepA, voffA);
            PG8_WAIT_L(8); PG8_BAR; PG8_WAIT_L(0); PG8_MMA(0, 0, At, B0); PG8_BAR; PG8_SCHED;
            PG8_LDB(B1, 1, 1); PG8_STAGE(PG8_SB(1, 0), b3, voffB);
            PG8_BAR; PG8_WAIT_L(0); PG8_MMA(0, 1, At, B1); PG8_BAR;
            PG8_LDA(At, 1, 1); PG8_STAGE(PG8_SA(1, 0), a3, voffA);
            PG8_BAR; PG8_WAIT_L(0); PG8_MMA(1, 0, At, B0); PG8_BAR; PG8_SCHED;
            PG8_STAGE(PG8_SB(1, 1), b3 + hstepB, voffB);
            PG8_WAIT_V(6); PG8_BAR; PG8_MMA(1, 1, At, B1); PG8_BAR;
            }
        }
        if constexpr (ALIGN_EPI) { if (wr == 0) PG8_BAR; }
        if constexpr (!Epi::AFTER_DRAIN) { E(acc, cur, wr, wc, fr, fq); S.done(cur); }
        if (!has_next) break;
#pragma unroll
        for (int a = 0; a < 2; ++a)
#pragma unroll
            for (int b = 0; b < 2; ++b)
#pragma unroll
                for (int m = 0; m < 4; ++m)
#pragma unroll
                    for (int n = 0; n < 2; ++n) acc[a][b][m][n] = (f32x4){0.f, 0.f, 0.f, 0.f};
        cur = nxt; cA = nA; cB = nB; ++ui;
        if constexpr (ALIGN_EPI) { if (wr == 1) PG8_BAR; }
    }
    PG8_WAIT_V(0);
    if constexpr (!ALIGN_EPI) { if (wr == 0) PG8_BAR; }
    PG8_BAR;
    if constexpr (Epi::AFTER_DRAIN) { E.fused(acc, cur, wr, wc, fr, fq, lds, wid, lane); S.done(cur); }
#undef PG8_SA
#undef PG8_SB
#undef PG8_STAGE
#undef PG8_LDA
#undef PG8_LDB
#undef PG8_MMA
#undef PG8_WAIT_V
#undef PG8_WAIT_L
#undef PG8_BAR
#undef PG8_SCHED
}
}

namespace att {
#define LAS __attribute__((address_space(3)))
typedef unsigned short bf16_t;
typedef LAS char* lptr;
using bf16x8 = __attribute__((ext_vector_type(8))) short;
using s16x4  = __attribute__((ext_vector_type(4))) short;
using f32x16 = __attribute__((ext_vector_type(16))) float;
using u32x4  = __attribute__((ext_vector_type(4))) unsigned;
constexpr int V_OFF = 0, K_OFF = 32768, WS_OFF = 67584, STASH_OFF = 69632, ATT_LDS_END = STASH_OFF + 65536;
#define SBAR() __builtin_amdgcn_sched_barrier(0)
__device__ __forceinline__ int crow(int r, int hi) { return (r & 3) + 8 * (r >> 2) + 4 * hi; }
__device__ __forceinline__ unsigned cvtpk(float lo, float hi) { unsigned r; asm volatile("v_cvt_pk_bf16_f32 %0, %1, %2" : "=v"(r) : "v"(lo), "v"(hi)); return r; }
__device__ __forceinline__ unsigned short f2bf(float f) { unsigned r; asm("v_cvt_pk_bf16_f32 %0, %1, %1" : "=v"(r) : "v"(f)); return (unsigned short)r; }

struct Args { const bf16_t *Q0, *Q1, *K0, *K1, *V; int ldq, ldk0, ldk1, ldv, nkeys; float C, thr; };

__device__ __forceinline__ void partialSM(f32x16& p0, f32x16& p1, float& m_reg, float& mn, float& alpha, float C, float thr) {
  float pmax = p0[0];
#pragma unroll
  for (int r = 1; r < 16; ++r) pmax = fmaxf(pmax, p0[r]);
#pragma unroll
  for (int r = 0; r < 16; ++r) pmax = fmaxf(pmax, p1[r]);
  { auto rr = __builtin_amdgcn_permlane32_swap(__float_as_uint(pmax), __float_as_uint(pmax), false, false);
    pmax = fmaxf(__uint_as_float(rr[0]), __uint_as_float(rr[1])); }
  if (__builtin_expect(__all(pmax - m_reg <= thr), 1)) { mn = m_reg; alpha = 1.f; }
  else { mn = fmaxf(m_reg, pmax); alpha = __builtin_amdgcn_exp2f((m_reg - mn) * C); m_reg = mn; }
  const float mnC = -mn * C;
#pragma unroll
  for (int r = 0; r < 16; ++r) p0[r] = fmaf(p0[r], C, mnC);
#pragma unroll
  for (int r = 0; r < 16; ++r) p1[r] = fmaf(p1[r], C, mnC);
#pragma unroll
  for (int r = 0; r < 16; ++r) p0[r] = __builtin_amdgcn_exp2f(p0[r]);
}
__device__ __forceinline__ void finishSM(f32x16& p0, f32x16& p1, float alpha, float& l_reg, bf16x8& pa0, bf16x8& pa1, bf16x8& pa2, bf16x8& pa3) {
#pragma unroll
  for (int r = 0; r < 16; ++r) p1[r] = __builtin_amdgcn_exp2f(p1[r]);
  float ps = 0;
#pragma unroll
  for (int r = 0; r < 16; ++r) ps += p0[r];
#pragma unroll
  for (int r = 0; r < 16; ++r) ps += p1[r];
  { auto rr = __builtin_amdgcn_permlane32_swap(__float_as_uint(ps), __float_as_uint(ps), false, false);
    ps = __uint_as_float(rr[0]) + __uint_as_float(rr[1]); }
  l_reg = l_reg * alpha + ps;
#define PK4(P, BASE, OUT) do { unsigned a0 = cvtpk(P[BASE + 0], P[BASE + 1]), a1 = cvtpk(P[BASE + 2], P[BASE + 3]);   \
    unsigned b0 = cvtpk(P[BASE + 4], P[BASE + 5]), b1 = cvtpk(P[BASE + 6], P[BASE + 7]);                              \
    auto r0 = __builtin_amdgcn_permlane32_swap(a0, b0, false, false); auto r1 = __builtin_amdgcn_permlane32_swap(a1, b1, false, false); \
    u32x4 w = {r0[0], r1[0], r0[1], r1[1]}; OUT = __builtin_bit_cast(bf16x8, w); } while (0)
  PK4(p0, 0, pa0); PK4(p0, 8, pa1); PK4(p1, 0, pa2); PK4(p1, 8, pa3);
#undef PK4
}
template <int NQ, int KROW> __device__ __forceinline__ void qkt(f32x16& p0, f32x16& p1, lptr Ks, const bf16x8* qr, int r32, int hi) {
  p0 = f32x16{}; p1 = f32x16{};
#pragma unroll
  for (int d0 = 0; d0 < NQ; ++d0) { const int cb = (d0 * 16 + hi * 8) * 2;
    const bf16x8 b0 = *(const LAS bf16x8*)(Ks + r32 * KROW + cb);
    const bf16x8 b1 = *(const LAS bf16x8*)(Ks + (32 + r32) * KROW + cb);
    p0 = __builtin_amdgcn_mfma_f32_32x32x16_bf16(b0, qr[d0], p0, 0, 0, 0);
    p1 = __builtin_amdgcn_mfma_f32_32x32x16_bf16(b1, qr[d0], p1, 0, 0, 0); }
}
template <int ND> __device__ __forceinline__ int v_st(int k, int c) { const int kk = (k & ~0xC) | ((k & 4) << 1) | ((k & 8) >> 1); return ((kk >> 3) * ND + (c >> 5)) * 512 + ((kk & 7) * 32 + (c & 31)) * 2; }
__device__ __forceinline__ int v_rd_base(int lane) { return ((lane & 3) << 3) | (((lane >> 2) & 3) << 6) | (((lane >> 4) & 1) << 5) | (((lane >> 5) & 1) << 8); }
template <int OFF> __device__ __forceinline__ s16x4 tr_read(int vb) {
  s16x4 r; asm volatile("ds_read_b64_tr_b16 %0, %1 offset:%2" : "=&v"(r) : "v"(vb), "i"(OFF) : "memory"); return r;
}
template <int ND, int D0> __device__ __forceinline__ void pv_one(f32x16& od, int vb, bf16x8 pa0, bf16x8 pa1, bf16x8 pa2, bf16x8 pa3) {
  constexpr int KG = ND * 512;
  const s16x4 l0 = tr_read<D0 * 512 + 0 * KG>(vb), h0 = tr_read<D0 * 512 + 1 * KG>(vb), l1 = tr_read<D0 * 512 + 2 * KG>(vb), h1 = tr_read<D0 * 512 + 3 * KG>(vb);
  const s16x4 l2 = tr_read<D0 * 512 + 4 * KG>(vb), h2 = tr_read<D0 * 512 + 5 * KG>(vb), l3 = tr_read<D0 * 512 + 6 * KG>(vb), h3 = tr_read<D0 * 512 + 7 * KG>(vb);
  asm volatile("s_waitcnt lgkmcnt(0)" ::: "memory"); SBAR();
#define PK(L, H) (bf16x8){L[0], L[1], L[2], L[3], H[0], H[1], H[2], H[3]}
  od = __builtin_amdgcn_mfma_f32_32x32x16_bf16(pa0, PK(l0, h0), od, 0, 0, 0);
  od = __builtin_amdgcn_mfma_f32_32x32x16_bf16(pa1, PK(l1, h1), od, 0, 0, 0);
  od = __builtin_amdgcn_mfma_f32_32x32x16_bf16(pa2, PK(l2, h2), od, 0, 0, 0);
  od = __builtin_amdgcn_mfma_f32_32x32x16_bf16(pa3, PK(l3, h3), od, 0, 0, 0);
#undef PK
}
template <int ND> __device__ __forceinline__ void pv_all(f32x16* o, int vb, bf16x8 pa0, bf16x8 pa1, bf16x8 pa2, bf16x8 pa3) {
  pv_one<ND, 0>(o[0], vb, pa0, pa1, pa2, pa3); pv_one<ND, 1>(o[1], vb, pa0, pa1, pa2, pa3);
  if constexpr (ND == 4) { pv_one<ND, 2>(o[2], vb, pa0, pa1, pa2, pa3); pv_one<ND, 3>(o[3], vb, pa0, pa1, pa2, pa3); }
}

template <int MODE> struct Cfg;
template <> struct Cfg<0> { static constexpr int DQK = 96, DV = 64; };
template <> struct Cfg<1> { static constexpr int DQK = 64, DV = 128; };
template <> struct Cfg<2> { static constexpr int DQK = 128, DV = 128; };

struct Slot { bf16x8 a, b, c, d; };

template <int MODE>
__device__ __forceinline__ void attn_core(const Args& A, lptr lds, f32x16* o, float* rli) {
  constexpr int DQK = Cfg<MODE>::DQK, DV = Cfg<MODE>::DV, NQ = DQK / 16, ND = DV / 32, KROW = DQK * 2 + 16, SHM_K = 64 * KROW, SHM_V = 64 * DV * 2;
  int tid_ = threadIdx.x; asm volatile("" : "+v"(tid_));
  const int tid = tid_, wid = tid >> 6, lane = tid & 63, r32 = lane & 31, hi = lane >> 5;
  const lptr V_lds = lds + V_OFF, K_lds = lds + K_OFF;
  LAS float* ws = (LAS float*)(lds + WS_OFF) + wid * 64; LAS float* li_l = ws; LAS float* al_l = ws + 32;
  float m_reg = -1e30f, l_reg = 0.f;
#pragma unroll
  for (int d = 0; d < ND; ++d) o[d] = f32x16{};
  bf16x8 qr[NQ];
  { const bf16_t* Qw = A.Q0 + (size_t)(wid * 32 + r32) * A.ldq + hi * 8;
    if constexpr (MODE == 0) {
#pragma unroll
      for (int d0 = 0; d0 < 4; ++d0) qr[d0] = *(const bf16x8*)(Qw + d0 * 16);
      const bf16_t* Qw1 = A.Q1 + (size_t)(wid * 32 + r32) * A.ldq + hi * 8;
      qr[4] = *(const bf16x8*)(Qw1); qr[5] = *(const bf16x8*)(Qw1 + 16);
    } else {
#pragma unroll
      for (int d0 = 0; d0 < NQ; ++d0) qr[d0] = *(const bf16x8*)(Qw + d0 * 16);
    } }
  const int vb0 = (int)(uintptr_t)V_lds + v_rd_base(lane);
  Slot sr_[2];
  const int r8 = tid >> 3, c8 = (tid & 7) * 8;
  const int r16 = tid >> 4, c16 = (tid & 15) * 8;
  const int rr4 = (tid & 255) >> 2, cr4 = (tid & 3) * 8;
#define SLOAD(i, k0) do { \
    if constexpr (MODE == 0) { sr_[i].a = *(const bf16x8*)(A.K0 + (size_t)((k0) + r8) * A.ldk0 + c8); sr_[i].b = *(const bf16x8*)(A.K1 + (size_t)((k0) + rr4) * A.ldk1 + cr4); \
                               sr_[i].c = *(const bf16x8*)(A.V + (size_t)((k0) + r8) * A.ldv + c8); } \
    else if constexpr (MODE == 1) { sr_[i].a = *(const bf16x8*)(A.K0 + (size_t)((k0) + r8) * A.ldk0 + c8); \
                               sr_[i].c = *(const bf16x8*)(A.V + (size_t)((k0) + r16) * A.ldv + c16); sr_[i].d = *(const bf16x8*)(A.V + (size_t)((k0) + 32 + r16) * A.ldv + c16); } \
    else { sr_[i].a = *(const bf16x8*)(A.K0 + (size_t)((k0) + r16) * A.ldk0 + c16); sr_[i].b = *(const bf16x8*)(A.K0 + (size_t)((k0) + 32 + r16) * A.ldk0 + c16); \
           sr_[i].c = *(const bf16x8*)(A.V + (size_t)((k0) + r16) * A.ldv + c16); sr_[i].d = *(const bf16x8*)(A.V + (size_t)((k0) + 32 + r16) * A.ldv + c16); } } while (0)
#define SWRITE(bf, i) do { const lptr Kb = K_lds + (bf) * SHM_K; const lptr Vb = V_lds + (bf) * SHM_V; \
    if constexpr (MODE == 0) { *(LAS bf16x8*)(Kb + r8 * KROW + c8 * 2) = sr_[i].a; if (tid < 256) *(LAS bf16x8*)(Kb + rr4 * KROW + 128 + cr4 * 2) = sr_[i].b; \
                               *(LAS bf16x8*)(Vb + v_st<ND>(r8, c8)) = sr_[i].c; } \
    else if constexpr (MODE == 1) { *(LAS bf16x8*)(Kb + r8 * KROW + c8 * 2) = sr_[i].a; \
                               *(LAS bf16x8*)(Vb + v_st<ND>(r16, c16)) = sr_[i].c; *(LAS bf16x8*)(Vb + v_st<ND>(32 + r16, c16)) = sr_[i].d; } \
    else { *(LAS bf16x8*)(Kb + r16 * KROW + c16 * 2) = sr_[i].a; *(LAS bf16x8*)(Kb + (32 + r16) * KROW + c16 * 2) = sr_[i].b; \
           *(LAS bf16x8*)(Vb + v_st<ND>(r16, c16)) = sr_[i].c; *(LAS bf16x8*)(Vb + v_st<ND>(32 + r16, c16)) = sr_[i].d; } } while (0)
#define SWAIT() do { if constexpr (MODE == 2) asm volatile("s_waitcnt vmcnt(4)" ::: "memory"); else asm volatile("s_waitcnt vmcnt(3)" ::: "memory"); } while (0)
#define ATT_BAR() asm volatile("s_waitcnt lgkmcnt(0)\n\ts_barrier" ::: "memory")
#define RESC(a) do { if (__any((a) < 1.f)) { if (hi == 0) al_l[r32] = (a); asm volatile("s_waitcnt lgkmcnt(0)" ::: "memory"); \
    _Pragma("unroll") for (int d = 0; d < ND; ++d) _Pragma("unroll") for (int r = 0; r < 16; ++r) o[d][r] *= al_l[crow(r, hi)]; } } while (0)
  f32x16 pA0, pA1, pB0, pB1; float mnA, mnB, alA, alB; bf16x8 pa0, pa1, pa2, pa3; const int NT = A.nkeys / 64;
  const float C = A.C, thr = A.thr;
  SLOAD(0, 0); asm volatile("s_waitcnt vmcnt(0)" ::: "memory"); SWRITE(0, 0); ATT_BAR();
  qkt<NQ, KROW>(pA0, pA1, K_lds, qr, r32, hi); partialSM(pA0, pA1, m_reg, mnA, alA, C, thr);
  SLOAD(1, 64); if (2 < NT) SLOAD(0, 128);
  SWAIT(); SWRITE(1, 1); ATT_BAR();
  for (int j = 1; j + 1 < NT; j += 2) {
    SBAR(); qkt<NQ, KROW>(pB0, pB1, K_lds + SHM_K, qr, r32, hi);
    finishSM(pA0, pA1, alA, l_reg, pa0, pa1, pa2, pa3); SBAR();
    SLOAD(1, (j + 2) * 64); SBAR();
    pv_all<ND>(o, vb0, pa0, pa1, pa2, pa3); partialSM(pB0, pB1, m_reg, mnB, alB, C, thr);
    ATT_BAR(); SWAIT(); SWRITE(0, 0);
    RESC(alB); ATT_BAR();
    SBAR(); qkt<NQ, KROW>(pA0, pA1, K_lds, qr, r32, hi);
    finishSM(pB0, pB1, alB, l_reg, pa0, pa1, pa2, pa3); SBAR();
    if (j + 3 < NT) SLOAD(0, (j + 3) * 64); SBAR();
    pv_all<ND>(o, vb0 + SHM_V, pa0, pa1, pa2, pa3); partialSM(pA0, pA1, m_reg, mnA, alA, C, thr);
    ATT_BAR(); SWAIT(); SWRITE(1, 1);
    RESC(alA); ATT_BAR();
  }
  SBAR(); qkt<NQ, KROW>(pB0, pB1, K_lds + SHM_K, qr, r32, hi);
  finishSM(pA0, pA1, alA, l_reg, pa0, pa1, pa2, pa3); SBAR();
  pv_all<ND>(o, vb0, pa0, pa1, pa2, pa3); partialSM(pB0, pB1, m_reg, mnB, alB, C, thr);
  ATT_BAR(); RESC(alB);
  finishSM(pB0, pB1, alB, l_reg, pa0, pa1, pa2, pa3); SBAR();
  pv_all<ND>(o, vb0 + SHM_V, pa0, pa1, pa2, pa3);
  if (hi == 0) li_l[r32] = l_reg; asm volatile("s_waitcnt lgkmcnt(0)" ::: "memory");
#pragma unroll
  for (int r = 0; r < 16; ++r) rli[r] = __builtin_amdgcn_rcpf(li_l[crow(r, hi)]);
  ATT_BAR();
#undef SLOAD
#undef SWRITE
#undef SWAIT
#undef RESC
#undef ATT_BAR
}
}

typedef unsigned short bf16;
typedef float f32x4 __attribute__((ext_vector_type(4)));
typedef unsigned v4u __attribute__((ext_vector_type(4)));
constexpr int T = 32768, DM = 1024, SEQ = 2048, NBATCH = 16, DEPTH = 4, MEMLEN = 256, NIN = 7328, DFF = 4096;
constexpr int NWAVES = 8, NTHREADS = 512;
constexpr float ALPHA = 1.6817928305074290f;
constexpr int LDS_BYTES = 139264;
static_assert(att::ATT_LDS_END <= LDS_BYTES && pg8::STAGE_BYTES <= LDS_BYTES, "LDS map");
constexpr size_t MiB = 1u << 20;
constexpr size_t WS_BAR = 512 * 1024;
constexpr size_t WS_RSQ = 0, WS_RSKV = 256 * 1024;
constexpr size_t WS_COSM = 1 * MiB, WS_SINM = 3 * MiB, WS_COSD = 5 * MiB, WS_SIND = 6 * MiB;
constexpr size_t WS_W = 8 * MiB;
constexpr size_t WS_MEMB = 48 * MiB, WS_MEMKV = 56 * MiB, WS_XB = 64 * MiB;
constexpr size_t WS_DQ = 128 * MiB, WS_MQ = 192 * MiB, WS_QM = 224 * MiB, WS_LAT = 272 * MiB, WS_DK = 320 * MiB, WS_DV = 384 * MiB, WS_KVM = 448 * MiB, WS_END = 512 * MiB;
constexpr size_t WS_G = 272 * MiB, WS_MG = 336 * MiB;
constexpr size_t WS_HID = 128 * MiB;
constexpr size_t WO_IN = 0, WO_G = WO_IN + (size_t)4352 * 1024, WO_UQ = WO_G + (size_t)3072 * 1024, WO_UKV = WO_UQ + (size_t)768 * 384, WO_MKV = WO_UKV + (size_t)1024 * 256,
                 WO_BM = WO_MKV + (size_t)1024 * 1024, WO_BD = WO_BM + (size_t)1024 * 512, WO_BE = WO_BD + (size_t)1024 * 1024, WO_OUT = WO_BE + (size_t)1024 * 512,
                 WO_1 = WO_OUT + (size_t)1024 * 1024, WO_2 = WO_1 + (size_t)4096 * 1024, WO_END = WO_2 + (size_t)4096 * 1024;
static_assert(WO_END * 2 <= 40 * MiB, "weight copies fit");

struct Params {
    const float *x, *mem; const int* pos;
    const float *w_in, *b_gate, *q_norm, *kv_norm, *w_uq, *w_ukv, *dlam, *subln, *w_mkv, *w_br, *w_out, *ln1g, *ln1b, *w1, *w2, *ln2g, *ln2b;
    float* out; unsigned char* ws;
};
typedef const __attribute__((address_space(4))) Params* kparams_t;
__device__ __forceinline__ kparams_t getp() { kparams_t kp = (kparams_t)__builtin_amdgcn_kernarg_segment_ptr(); asm volatile("" : "+s"(kp)); return kp; }

#define LDS_WAIT() asm volatile("s_waitcnt lgkmcnt(0)" ::: "memory")
__device__ __forceinline__ unsigned f2bf_u(float f) { unsigned u = __builtin_bit_cast(unsigned, f); return (u + 0x7fffu + ((u >> 16) & 1u)) >> 16; }
__device__ __forceinline__ unsigned pk2(float lo, float hi) { unsigned r; asm("v_cvt_pk_bf16_f32 %0, %1, %2" : "=v"(r) : "v"(lo), "v"(hi)); return r; }
__device__ __forceinline__ float wave_sum(float v) {
#pragma unroll
    for (int o = 1; o < 64; o <<= 1) v += __shfl_xor(v, o);
    return v;
}

__device__ __forceinline__ void tr_item(const float* W, int ldw, int sc, int K, bf16* WT, int n0, int k0, const float* gain, LAS float* scr, int lane) {
    float vv[32];
#pragma unroll
    for (int i = 0; i < 32; ++i) { const int kk = 2 * i + (lane >> 5); vv[i] = (sc >= 0) ? __builtin_nontemporal_load(W + (size_t)(k0 + kk) * ldw + sc + (lane & 31)) : 0.f; }
#pragma unroll
    for (int i = 0; i < 32; ++i) { const int kk = 2 * i + (lane >> 5); float v = vv[i]; if (sc >= 0 && gain) v *= gain[k0 + kk]; scr[kk * 33 + (lane & 31)] = v; }
    LDS_WAIT(); asm volatile("" ::: "memory");
    const int c = lane & 7;
#pragma unroll
    for (int j = 0; j < 4; ++j) { const int n = (lane >> 3) + 8 * j; const LAS float* s = scr + (8 * c) * 33 + n;
        v4u o; o.x = pk2(s[0 * 33], s[1 * 33]); o.y = pk2(s[2 * 33], s[3 * 33]); o.z = pk2(s[4 * 33], s[5 * 33]); o.w = pk2(s[6 * 33], s[7 * 33]);
        *(v4u*)(WT + (size_t)(n0 + n) * K + k0 + 8 * c) = o; }
    LDS_WAIT(); asm volatile("" ::: "memory");
}
__device__ __forceinline__ bool tr_job(int& it, const float* W, int ldw, int K, int N, bf16* WT, int kind, int coff, const float* gain, LAS float* scr, int lane) {
    const int nblk = N / 32, items = (K / 64) * nblk;
    if (it >= items) { it -= items; return false; }
    const int kb = it / nblk, nb = it % nblk, n0 = 32 * nb; int sc;
    if (kind == 0) sc = n0 + coff;
    else if (kind == 1) sc = (n0 < 672) ? n0 : (n0 < 768 ? -1 : n0 - 96);
    else sc = (n0 < 512) ? (n0 >> 6) * 96 + (n0 & 63) : ((n0 - 512) >> 5) * 96 + 64;
    tr_item(W, ldw, sc, K, WT, n0, 64 * kb, gain, scr, lane);
    return true;
}
__device__ __forceinline__ void convert_weights(int l, LAS unsigned char* lds, int gw, int NGW, int wave, int lane_) {
    int lane = lane_; asm volatile("" : "+v"(lane)); const kparams_t kp = getp();
    LAS float* scr = (LAS float*)(lds + wave * 16384);
    bf16* Wb = (bf16*)(kp->ws + WS_W);
    const float* w_in = kp->w_in + (size_t)l * DM * NIN; const float* wbr = kp->w_br + (size_t)l * 2048 * 1024;
    constexpr int NITEMS = 16 * 136 + 16 * 96 + 6 * 24 + 4 * 32 + 16 * 32 + 8 * 32 + 16 * 32 + 8 * 32 + 16 * 32 + 16 * 128 + 64 * 32;
    for (int item = gw; item < NITEMS; item += NGW) {
        int it = item;
        if (tr_job(it, w_in, NIN, 1024, 4352, Wb + WO_IN, 1, 0, nullptr, scr, lane)) continue;
        if (tr_job(it, w_in, NIN, 1024, 3072, Wb + WO_G, 0, 4256, nullptr, scr, lane)) continue;
        if (tr_job(it, kp->w_uq + (size_t)l * 384 * 768, 768, 384, 768, Wb + WO_UQ, 2, 0, kp->q_norm + l * 384, scr, lane)) continue;
        if (tr_job(it, kp->w_ukv + (size_t)l * 256 * 1024, 1024, 256, 1024, Wb + WO_UKV, 0, 0, kp->kv_norm + l * 256, scr, lane)) continue;
        if (tr_job(it, kp->w_mkv + (size_t)l * 1024 * 1024, 1024, 1024, 1024, Wb + WO_MKV, 0, 0, nullptr, scr, lane)) continue;
        if (tr_job(it, wbr, 1024, 512, 1024, Wb + WO_BM, 0, 0, nullptr, scr, lane)) continue;
        if (tr_job(it, wbr + (size_t)512 * 1024, 1024, 1024, 1024, Wb + WO_BD, 0, 0, nullptr, scr, lane)) continue;
        if (tr_job(it, wbr + (size_t)1536 * 1024, 1024, 512, 1024, Wb + WO_BE, 0, 0, nullptr, scr, lane)) continue;
        if (tr_job(it, kp->w_out + (size_t)l * 1024 * 1024, 1024, 1024, 1024, Wb + WO_OUT, 0, 0, nullptr, scr, lane)) continue;
        if (tr_job(it, kp->w1 + (size_t)l * 1024 * 4096, 4096, 1024, 4096, Wb + WO_1, 0, 0, nullptr, scr, lane)) continue;
        tr_job(it, kp->w2 + (size_t)l * 4096 * 1024, 1024, 4096, 1024, Wb + WO_2, 0, 0, nullptr, scr, lane);
    }
}
__device__ __forceinline__ void ln_rows(float* X, bf16* XB, const float* g, const float* b, int gw, int NGW, int lane_, int row_end = T) {
    int lane = lane_; asm volatile("" : "+v"(lane));
    f32x4 gv[4], bv[4];
#pragma unroll
    for (int j = 0; j < 4; ++j) { gv[j] = ((const f32x4*)g)[lane + 64 * j]; bv[j] = ((const f32x4*)b)[lane + 64 * j]; }
    for (int m = gw; m < row_end; m += 2 * NGW) {
        const int m2 = (m + NGW < row_end) ? m + NGW : m;
        f32x4* xr = (f32x4*)(X + (size_t)m * DM) + lane; f32x4* xr2 = (f32x4*)(X + (size_t)m2 * DM) + lane; f32x4 v[4], w[4]; float s = 0.f, t = 0.f;
#pragma unroll
        for (int j = 0; j < 4; ++j) { v[j] = xr[64 * j]; w[j] = xr2[64 * j]; }
#pragma unroll
        for (int j = 0; j < 4; ++j) { s += (v[j].x + v[j].y) + (v[j].z + v[j].w); t += (w[j].x + w[j].y) + (w[j].z + w[j].w); }
        const float mean = wave_sum(s) * (1.f / DM), mean2 = wave_sum(t) * (1.f / DM); float s2 = 0.f, t2 = 0.f;
#pragma unroll
        for (int j = 0; j < 4; ++j) { v[j] = v[j] - mean; s2 += (v[j].x * v[j].x + v[j].y * v[j].y) + (v[j].z * v[j].z + v[j].w * v[j].w);
                                      w[j] = w[j] - mean2; t2 += (w[j].x * w[j].x + w[j].y * w[j].y) + (w[j].z * w[j].z + w[j].w * w[j].w); }
        const float rstd = 1.f / sqrtf(wave_sum(s2) * (1.f / DM) + 1e-5f), rstd2 = 1.f / sqrtf(wave_sum(t2) * (1.f / DM) + 1e-5f);
        unsigned long long* o8 = (unsigned long long*)(XB + (size_t)m * DM) + lane; unsigned long long* o82 = (unsigned long long*)(XB + (size_t)m2 * DM) + lane;
#pragma unroll
        for (int j = 0; j < 4; ++j) { const f32x4 y = v[j] * rstd * gv[j] + bv[j]; xr[64 * j] = y;
            o8[64 * j] = (unsigned long long)pk2(y.x, y.y) | ((unsigned long long)pk2(y.z, y.w) << 32); }
        if (m2 != m) {
#pragma unroll
        for (int j = 0; j < 4; ++j) { const f32x4 y = w[j] * rstd2 * gv[j] + bv[j]; xr2[64 * j] = y;
            o82[64 * j] = (unsigned long long)pk2(y.x, y.y) | ((unsigned long long)pk2(y.z, y.w) << 32); } }
    }
}
__device__ __forceinline__ void rowscale_rows(const bf16* lat, float* rsq, float* rskv, int gw, int NGW, int lane_) {
    int lane = lane_; asm volatile("" : "+v"(lane));
    for (int row = gw; row < T; row += 4 * NGW) {
        unsigned w[4][5];
#pragma unroll
        for (int q = 0; q < 4; ++q) { const int rq = (row + q * NGW < T) ? row + q * NGW : row; const unsigned* src = (const unsigned*)(lat + (size_t)rq * 768) + lane;
#pragma unroll
            for (int k = 0; k < 5; ++k) w[q][k] = src[64 * k]; }
#pragma unroll
        for (int q = 0; q < 4; ++q) { float sq = 0.f, sk = 0.f;
#pragma unroll
            for (int k = 0; k < 5; ++k) { const float a = __uint_as_float(w[q][k] << 16), b = __uint_as_float(w[q][k] & 0xffff0000u); if (k < 3) sq += a * a + b * b; else sk += a * a + b * b; }
            sq = wave_sum(sq); sk = wave_sum(sk);
            if (lane == 0 && row + q * NGW < T) { rsq[row + q * NGW] = 1.0f / sqrtf(sq * (1.f / 384.f) + 1e-6f); rskv[row + q * NGW] = 1.0f / sqrtf(sk * (1.f / 256.f) + 1e-6f); } }
    }
}

#ifndef PH_MASK
#define PH_MASK 0xffff
#endif

#define WSP(T_, off) ((T_*)(ws + (off)))
#define XB_TMO      128
#define XB_XCNT(j)  (256  + 64 * (j))
#define XB_XSUB(j)  (1280 + 64 * (j))
#define XB_XGEN(j)  (2304 + 64 * (j))
#define XB_TOP      3328
#define XB_TOPGEN   3392
#define XCD_BAR_WORDS 3456
#define XB_SPIN_CAP (1u << 18)

__device__ __forceinline__ unsigned xb_ld(unsigned* p)              { return __hip_atomic_load(p, __ATOMIC_RELAXED, __HIP_MEMORY_SCOPE_AGENT); }
__device__ __forceinline__ unsigned xb_add(unsigned* p, unsigned v) { return __hip_atomic_fetch_add(p, v, __ATOMIC_RELAXED, __HIP_MEMORY_SCOPE_AGENT); }
__device__ __forceinline__ unsigned xb_xcc_id() { return (unsigned)__builtin_amdgcn_s_getreg((3 << 11) | 20) & 0xFu; }
#define XB_SPIN(cond, bar) do { unsigned _sp = 0; while (cond) { __builtin_amdgcn_s_sleep(1); \
    if ((++_sp & 255u) == 0u) { if (xb_ld(&(bar)[XB_TMO])) break; if (_sp > XB_SPIN_CAP) { atomicAdd(&(bar)[XB_TMO], 1u); break; } } } } while (0)

struct XcdBarrier {
    unsigned* bar; unsigned x;
    volatile LAS unsigned* st;
};

__device__ __forceinline__ XcdBarrier xcd_barrier_post(unsigned* bar, volatile LAS unsigned* st) {
    XcdBarrier b; b.bar = bar; b.x = xb_xcc_id(); b.st = st;
    if (threadIdx.x == 0) (void)xb_add(&bar[XB_XCNT(b.x)], 1u);
    return b;
}
__device__ __forceinline__ void xcd_barrier_complete(unsigned* bar, unsigned x, unsigned& nloc, unsigned& nx) {
    const unsigned G = gridDim.x * gridDim.y * gridDim.z;
    unsigned sum, cnt, mine, sp = 0u;
    for (;;) {
        sum = 0u; cnt = 0u; mine = 0u;
#pragma unroll
        for (unsigned j = 0; j < 16; ++j) { const unsigned c = xb_ld(&bar[XB_XCNT(j)]); sum += c; cnt += (c > 0u) ? 1u : 0u; mine = (j == x) ? c : mine; }
        if (sum == G) break;
        __builtin_amdgcn_s_sleep(1);
        if ((++sp & 255u) == 0u) { if (xb_ld(&bar[XB_TMO])) break; if (sp > XB_SPIN_CAP) { atomicAdd(&bar[XB_TMO], 1u); break; } }
    }
    nloc = mine > 0u ? mine : 1u; nx = cnt > 0u ? cnt : 1u;
}

__device__ __forceinline__ void xcd_barrier(const XcdBarrier& b) {
    asm volatile("s_waitcnt vmcnt(0)" ::: "memory");
    __syncthreads();
    if (threadIdx.x == 0) {
        unsigned* bar = b.bar;
        __builtin_amdgcn_s_waitcnt(0);
        unsigned nloc = b.st[0], nx = b.st[1];
        if (nloc == 0u) { xcd_barrier_complete(bar, b.x, nloc, nx); b.st[0] = nloc; b.st[1] = nx; }
        const unsigned old = xb_add(&bar[XB_XSUB(b.x)], 1u);
        const unsigned gen = old / nloc;
        if (old + 1u == (gen + 1u) * nloc) {
            __builtin_amdgcn_fence(__ATOMIC_RELEASE, "agent");
            asm volatile("s_waitcnt vmcnt(0)" ::: "memory");
            const unsigned og = xb_add(&bar[XB_TOP], 1u);
            const unsigned tg = og / nx;
            if (og + 1u == (tg + 1u) * nx) xb_add(&bar[XB_TOPGEN], 1u);
            else XB_SPIN(xb_ld(&bar[XB_TOPGEN]) == tg, bar);
            __builtin_amdgcn_fence(__ATOMIC_ACQUIRE, "agent");
            xb_add(&bar[XB_XGEN(b.x)], 1u);
            asm volatile("s_waitcnt vmcnt(0)" ::: "memory");
        } else {
            XB_SPIN(xb_ld(&bar[XB_XGEN(b.x)]) == gen, bar);
            __builtin_amdgcn_fence(__ATOMIC_ACQUIRE, "agent");
            asm volatile("s_waitcnt vmcnt(0)" ::: "memory");
        }
    }
    __syncthreads();
}

#define GRID_SYNC() do { XcdBarrier xb_; xb_.bar = (unsigned*)(getp()->ws + WS_BAR); xb_.x = xb_xcc_id(); xb_.st = (volatile LAS unsigned*)(lds + LDS_BYTES - 64); xcd_barrier(xb_); } while (0)
__global__ void __launch_bounds__(NTHREADS, 2) fwd_megakernel(Params p_unused) {
    extern __shared__ __attribute__((aligned(16))) unsigned char lds_raw[];
    cg::grid_group grid = cg::this_grid();
    LAS unsigned char* lds = (LAS unsigned char*)lds_raw;
    const int tid = threadIdx.x, lane = tid & 63, wave = __builtin_amdgcn_readfirstlane(tid >> 6);
    const int G = gridDim.x, bx = blockIdx.x;
    const int vcu = (G % 8 == 0) ? (bx % 8) * (G / 8) + bx / 8 : bx;
    const int gw = vcu * NWAVES + wave, NGW = G * NWAVES;
    volatile LAS unsigned* xst = (volatile LAS unsigned*)(lds + LDS_BYTES - 64);
    if (tid < 2) xst[tid] = 0u;
    __syncthreads();
    (void)xcd_barrier_post((unsigned*)(getp()->ws + WS_BAR), xst);
    grid.sync();

#if (PH_MASK & 1)
    {   const kparams_t kp = getp(); unsigned char* ws = kp->ws; float* X = kp->out; const float* xin = kp->x; const float* memin = kp->mem; const int* pos = kp->pos;
        bf16 *XB = WSP(bf16, WS_XB), *MEMB = WSP(bf16, WS_MEMB);
        float *COSM = WSP(float, WS_COSM), *SINM = WSP(float, WS_SINM), *COSD = WSP(float, WS_COSD), *SIND = WSP(float, WS_SIND);
        const long gt = (long)bx * NTHREADS + tid, NGT = (long)G * NTHREADS;
        for (long i = gt; i < (long)T * DM / 4; i += 4 * NGT) { f32x4 v[4];
#pragma unroll
            for (int q = 0; q < 4; ++q) v[q] = (i + q * NGT < (long)T * DM / 4) ? __builtin_nontemporal_load((const f32x4*)xin + i + q * NGT) : (f32x4){0.f, 0.f, 0.f, 0.f};
#pragma unroll
            for (int q = 0; q < 4; ++q) if (i + q * NGT < (long)T * DM / 4) { ((f32x4*)X)[i + q * NGT] = v[q];
                ((unsigned long long*)XB)[i + q * NGT] = (unsigned long long)pk2(v[q].x, v[q].y) | ((unsigned long long)pk2(v[q].z, v[q].w) << 32); } }
        for (long i = gt; i < (long)NBATCH * MEMLEN * DM / 4; i += NGT) { const f32x4 v = __builtin_nontemporal_load((const f32x4*)memin + i);
            ((unsigned long long*)MEMB)[i] = (unsigned long long)pk2(v.x, v.y) | ((unsigned long long)pk2(v.z, v.w) << 32); }
        for (long i = gt; i < (long)T * 16; i += NGT) { const int t = (int)(i >> 4), j = (int)(i & 15); const float inv = exp2f(-(float)(2 * j) * (18.931568569324174f / 32.f)); const float ang = (float)pos[t] * inv;
            const double a = (double)ang, n = rint(a * 0.15915494309189535), r = a - n * 6.283185307179586;
            COSM[i] = (float)cos(r); SINM[i] = (float)sin(r); }
        for (long i = gt; i < (long)T * 8; i += NGT) { const int t = (int)(i >> 3), j = (int)(i & 7); const float inv = exp2f(-(float)(2 * j) * (18.931568569324174f / 16.f)); const float ang = (float)pos[t] * inv;
            const double a = (double)ang, n = rint(a * 0.15915494309189535), r = a - n * 6.283185307179586;
            COSD[i] = (float)cos(r); SIND[i] = (float)sin(r); }
        convert_weights(0, lds, gw, NGW, wave, lane);
    }
    GRID_SYNC();
#endif

    for (int l = 0; l < DEPTH; ++l) {
        const float lambda_init = 0.8f - 0.6f * __expf(-0.3f * (float)l);
#if (PH_MASK & 2)
        {   const kparams_t kp = getp(); unsigned char* ws = kp->ws; bf16* Wb = WSP(bf16, WS_W);
            {   pg8::Gemm g{WSP(bf16, WS_XB), Wb + WO_IN, T, 4352, 1024, 1024, 1024}; pg8::StaticOrder S; S.init(T, 4352, G, bx);
                pg8::EpiH E{WSP(bf16, WS_LAT), WSP(bf16, WS_DQ), WSP(bf16, WS_DK), WSP(bf16, WS_DV), WSP(bf16, WS_MQ), WSP(float, WS_COSD), WSP(float, WS_SIND), WSP(float, WS_COSM), WSP(float, WS_SINM)};
                pg8::gemm_phase<pg8::EpiH, pg8::StaticOrder, true, true>(lds, g, S, E); }
            {   pg8::Gemm g{WSP(bf16, WS_MEMB), Wb + WO_MKV, NBATCH * MEMLEN, 1024, 1024, 1024, 1024}; pg8::StaticOrder S; S.init(NBATCH * MEMLEN, 1024, G, (bx + G / 2) % G);
                pg8::EpiScale<false> E{WSP(bf16, WS_MEMKV), 1024, nullptr, nullptr, nullptr};
                pg8::gemm_phase<pg8::EpiScale<false>, pg8::StaticOrder, true, true>(lds, g, S, E); } }
        GRID_SYNC();
#endif
#if (PH_MASK & 4)
        {   const kparams_t kp = getp(); unsigned char* ws = kp->ws; bf16* Wb = WSP(bf16, WS_W); bf16* LAT = WSP(bf16, WS_LAT); float *RSQ = WSP(float, WS_RSQ), *RSKV = WSP(float, WS_RSKV);
            rowscale_rows(LAT, RSQ, RSKV, gw, NGW, lane);
            GRID_SYNC();
            pg8::StaticOrder Sq; Sq.init(T, 768, G, bx); pg8::StaticOrder Skv; Skv.init(T, 1024, G, bx);
            {   pg8::Gemm g{LAT, Wb + WO_UQ, T, 768, 384, 768, 384}; pg8::EpiScale<true> E{WSP(bf16, WS_QM), 768, RSQ, WSP(float, WS_COSM), WSP(float, WS_SINM)};
                pg8::gemm_phase<pg8::EpiScale<true>, pg8::StaticOrder, true, true>(lds, g, Sq, E); }
            {   pg8::Gemm g{LAT + 384, Wb + WO_UKV, T, 1024, 256, 768, 256}; pg8::EpiScale<false> E{WSP(bf16, WS_KVM), 1024, RSKV, nullptr, nullptr};
                pg8::gemm_phase<pg8::EpiScale<false>, pg8::StaticOrder, true, true>(lds, g, Skv, E); } }
        GRID_SYNC();
#endif
        {
            const att::lptr alds = (att::lptr)lds;
            { const int rep = 1;
            int lane_a = lane; asm volatile("" : "+v"(lane_a)); const int r32 = lane_a & 31, hi = lane_a >> 5;
#if (PH_MASK & 8)
            {   const kparams_t kp = getp(); unsigned char* ws = kp->ws; bf16 *DQ = WSP(bf16, WS_DQ), *DK = WSP(bf16, WS_DK), *DV = WSP(bf16, WS_DV);
                float lam;
                {   const float* dl = kp->dlam + (size_t)l * 256; const float a = wave_sum(dl[lane_a] * dl[64 + lane_a]), b2 = wave_sum(dl[128 + lane_a] * dl[192 + lane_a]);
                    lam = __expf(a) - __expf(b2) + lambda_init; }
                const float* subln = kp->subln + l * 128;
                for (int idx = vcu; idx < NBATCH * 8 * 8; idx += G) {
                    const int bh = idx >> 3, qb = idx & 7, b = bh >> 3, h = bh & 7; const size_t row0 = (size_t)b * SEQ + qb * 256, key0 = (size_t)b * SEQ;
                    att::f32x16 o[4]; float rli[16];
                    att::Args A; A.ldq = 1024; A.ldk0 = 1024; A.ldk1 = 0; A.ldv = 1024; A.nkeys = SEQ; A.C = 0.125f * 1.4426950408889634f; A.thr = 8.f / 0.125f; A.Q1 = nullptr; A.K1 = nullptr;
                    A.Q0 = DQ + row0 * 1024 + h * 128; A.K0 = DK + key0 * 1024 + h * 128; A.V = DV + key0 * 1024 + h * 128;
                    att::attn_core<1>(A, alds, o, rli);
                    int ls = lane_a; asm volatile("" : "+v"(ls)); LAS unsigned* stash = (LAS unsigned*)(lds + att::STASH_OFF) + wave * 2048 + ls;
#pragma unroll
                    for (int d = 0; d < 4; ++d)
#pragma unroll
                        for (int j = 0; j < 8; ++j) stash[(d * 8 + j) * 64] = att::cvtpk(o[d][2 * j] * rli[2 * j], o[d][2 * j + 1] * rli[2 * j + 1]);
                    A.Q0 += 64; A.K0 += 64;
                    att::attn_core<1>(A, alds, o, rli);
                    float ss[16];
#pragma unroll
                    for (int r = 0; r < 16; ++r) ss[r] = 0.f;
#pragma unroll
                    for (int d = 0; d < 4; ++d)
#pragma unroll
                        for (int j = 0; j < 8; ++j) { const unsigned w = stash[(d * 8 + j) * 64];
                            const float d0v = __uint_as_float(w << 16) - lam * (o[d][2 * j] * rli[2 * j]), d1v = __uint_as_float(w & 0xffff0000u) - lam * (o[d][2 * j + 1] * rli[2 * j + 1]);
                            o[d][2 * j] = d0v; o[d][2 * j + 1] = d1v; ss[2 * j] += d0v * d0v; ss[2 * j + 1] += d1v * d1v; }
#pragma unroll
                    for (int r = 0; r < 16; ++r) { float s = ss[r]; s += __shfl_xor(s, 1); s += __shfl_xor(s, 2); s += __shfl_xor(s, 4); s += __shfl_xor(s, 8); s += __shfl_xor(s, 16);
                        ss[r] = (1.0f / sqrtf(s * (1.f / 128.f) + 1e-5f)) * (1.f - lambda_init); }
                    int lq = lane_a; asm volatile("" : "+v"(lq));
                    bf16* Ob = DQ + (row0 + wave * 32 + 4 * (lq >> 5)) * 1024 + h * 128 + (lq & 31);
#pragma unroll
                    for (int d = 0; d < 4; ++d) { const float gsub = subln[d * 32 + (lq & 31)];
#pragma unroll
                        for (int r = 0; r < 16; ++r) if (rep) Ob[att::crow(r, 0) * 1024 + d * 32] = att::f2bf(o[d][r] * ss[r] * gsub); }
                } }
#endif
#if (PH_MASK & 16)
            {   const kparams_t kp = getp(); unsigned char* ws = kp->ws; bf16 *QM = WSP(bf16, WS_QM), *KVM = WSP(bf16, WS_KVM), *LAT = WSP(bf16, WS_LAT);
                for (int idx = vcu; idx < NBATCH * 8 * 8; idx += G) {
                    const int bh = idx >> 3, qb = idx & 7, b = bh >> 3, h = bh & 7; const size_t row0 = (size_t)b * SEQ + qb * 256, key0 = (size_t)b * SEQ;
                    att::f32x16 o[2]; float rli[16];
                    att::Args A; A.ldq = 768; A.ldk0 = 1024; A.ldk1 = 768; A.ldv = 1024; A.nkeys = SEQ; A.C = 0.10206207261596575f * 1.4426950408889634f; A.thr = 8.f / 0.10206207261596575f;
                    A.Q0 = QM + row0 * 768 + h * 64; A.Q1 = QM + row0 * 768 + 512 + h * 32; A.K0 = KVM + key0 * 1024 + h * 128; A.K1 = LAT + key0 * 768 + 640; A.V = KVM + key0 * 1024 + h * 128 + 64;
                    att::attn_core<0>(A, alds, o, rli);
                    int lq = lane_a; asm volatile("" : "+v"(lq));
                    bf16* Ob = QM + (row0 + wave * 32 + 4 * (lq >> 5)) * 768 + h * 64 + (lq & 31);
#pragma unroll
                    for (int d = 0; d < 2; ++d)
#pragma unroll
                        for (int r = 0; r < 16; ++r) if (rep) Ob[att::crow(r, 0) * 768 + d * 32] = att::f2bf(o[d][r] * rli[r]);
                } }
#endif
#if (PH_MASK & 32)
            {   const kparams_t kp = getp(); unsigned char* ws = kp->ws; bf16 *MQ = WSP(bf16, WS_MQ), *MEMKV = WSP(bf16, WS_MEMKV);
                for (int idx = vcu; idx < NBATCH * 4 * 8; idx += G) {
                    const int bh = idx >> 3, qb = idx & 7, b = bh >> 2, h = bh & 3; const size_t row0 = (size_t)b * SEQ + qb * 256, key0 = (size_t)b * MEMLEN;
                    att::f32x16 o[4]; float rli[16];
                    att::Args A; A.ldq = 512; A.ldk0 = 1024; A.ldk1 = 0; A.ldv = 1024; A.nkeys = MEMLEN; A.C = 0.08838834764831845f * 1.4426950408889634f; A.thr = 8.f / 0.08838834764831845f; A.Q1 = nullptr; A.K1 = nullptr;
                    A.Q0 = MQ + row0 * 512 + h * 128; A.K0 = MEMKV + key0 * 1024 + h * 128; A.V = MEMKV + key0 * 1024 + 512 + h * 128;
                    att::attn_core<2>(A, alds, o, rli);
                    int lq = lane_a; asm volatile("" : "+v"(lq));
                    bf16* Ob = MQ + (row0 + wave * 32 + 4 * (lq >> 5)) * 512 + h * 128 + (lq & 31);
#pragma unroll
                    for (int d = 0; d < 4; ++d)
#pragma unroll
                        for (int r = 0; r < 16; ++r) if (rep) Ob[att::crow(r, 0) * 512 + d * 32] = att::f2bf(o[d][r] * rli[r]);
                } }
#endif
            }
        }
        GRID_SYNC();
#if (PH_MASK & 64)
        {   const kparams_t kp = getp(); unsigned char* ws = kp->ws; bf16* Wb = WSP(bf16, WS_W); bf16 *XB = WSP(bf16, WS_XB), *GB = WSP(bf16, WS_G), *MG = WSP(bf16, WS_MG);
            pg8::StaticOrder S; S.init(T, 1024, G, bx); const float* bg = kp->b_gate + (size_t)l * 3 * 1024;
            {
            {   pg8::Gemm g{XB, Wb + WO_G, T, 1024, 1024, 1024, 1024}; pg8::EpiGate E{GB, bg};
                pg8::gemm_phase<pg8::EpiGate, pg8::StaticOrder, true, true>(lds, g, S, E); }
            {   pg8::Gemm g{WSP(bf16, WS_QM), Wb + WO_BM, T, 1024, 512, 768, 512}; pg8::EpiBranch<true> E{GB, MG};
                pg8::gemm_phase<pg8::EpiBranch<true>, pg8::StaticOrder, true, true>(lds, g, S, E); }
            {   pg8::Gemm g{XB, Wb + WO_G + (size_t)1024 * 1024, T, 1024, 1024, 1024, 1024}; pg8::EpiGate E{GB, bg + 1024};
                pg8::gemm_phase<pg8::EpiGate, pg8::StaticOrder, true, true>(lds, g, S, E); }
            {   pg8::Gemm g{WSP(bf16, WS_DQ), Wb + WO_BD, T, 1024, 1024, 1024, 1024}; pg8::EpiBranch<false> E{GB, MG};
                pg8::gemm_phase<pg8::EpiBranch<false>, pg8::StaticOrder, true, true>(lds, g, S, E); }
            {   pg8::Gemm g{XB, Wb + WO_G + (size_t)2048 * 1024, T, 1024, 1024, 1024, 1024}; pg8::EpiGate E{GB, bg + 2048};
                pg8::gemm_phase<pg8::EpiGate, pg8::StaticOrder, true, true>(lds, g, S, E); }
            {   pg8::Gemm g{WSP(bf16, WS_MQ), Wb + WO_BE, T, 1024, 512, 512, 512}; pg8::EpiBranch<false> E{GB, MG};
                pg8::gemm_phase<pg8::EpiBranch<false>, pg8::StaticOrder, true, true>(lds, g, S, E); } } }
        GRID_SYNC();
#endif
#if (PH_MASK & 128)
        {   const kparams_t kp = getp(); unsigned char* ws = kp->ws;
            pg8::Gemm g{WSP(bf16, WS_MG), WSP(bf16, WS_W) + WO_OUT, T, 1024, 1024, 1024, 1024}; pg8::StaticOrder S; S.init(T, 1024, G, bx); pg8::EpiRes E{kp->out, ALPHA};
            pg8::gemm_phase<pg8::EpiRes, pg8::StaticOrder, true, true>(lds, g, S, E); }
        GRID_SYNC();
#endif
        {   const kparams_t kp = getp(); unsigned char* ws = kp->ws;
            ln_rows(kp->out, WSP(bf16, WS_XB), kp->ln1g + l * DM, kp->ln1b + l * DM, gw, NGW, lane); }
        GRID_SYNC();
#if (PH_MASK & 256)
        {   const kparams_t kp = getp(); unsigned char* ws = kp->ws;
            pg8::Gemm g{WSP(bf16, WS_XB), WSP(bf16, WS_W) + WO_1, T, 4096, 1024, 1024, 1024}; pg8::StaticOrder S; S.init(T, 4096, G, bx); pg8::EpiRelu2 E{WSP(bf16, WS_HID), 4096};
            pg8::gemm_phase<pg8::EpiRelu2, pg8::StaticOrder, true, true>(lds, g, S, E); }
        GRID_SYNC();
#endif
#if (PH_MASK & 512)
        {   const kparams_t kp = getp(); unsigned char* ws = kp->ws;
            pg8::Gemm g{WSP(bf16, WS_HID), WSP(bf16, WS_W) + WO_2, T, 1024, 4096, 4096, 4096}; pg8::StaticOrder S; S.init(T, 1024, G, bx); pg8::EpiRes E{kp->out, ALPHA};
            pg8::gemm_phase<pg8::EpiRes, pg8::StaticOrder, true, true>(lds, g, S, E); }
        GRID_SYNC();
#endif
        {   const kparams_t kp = getp(); unsigned char* ws = kp->ws;
            ln_rows(kp->out, WSP(bf16, WS_XB), kp->ln2g + l * DM, kp->ln2b + l * DM, gw, NGW, lane); }
        if (l + 1 < DEPTH) { convert_weights(l + 1, lds, gw, NGW, wave, lane); GRID_SYNC(); }
    }
}

extern "C" void kernel_launch(void* const* d_in, const int* in_sizes, int n_in, void* d_out, int out_size, void* d_ws, size_t ws_size, hipStream_t stream) {
    static int grid = 0;
    if (grid == 0) {
        if (n_in != 20 || in_sizes[0] != T * DM || out_size != T * DM || ws_size < WS_END) {
            fprintf(stderr, "kernel_launch: unexpected shapes (n_in %d, in0 %d, out %d, ws %zu; need ws >= %zu); nothing launched\n", n_in, n_in > 0 ? in_sizes[0] : -1, out_size, ws_size, (size_t)WS_END); grid = -1; return; }
        int dev = 0, cus = 0, per_cu = 0;
        if (hipGetDevice(&dev) != hipSuccess || hipDeviceGetAttribute(&cus, hipDeviceAttributeMultiprocessorCount, dev) != hipSuccess) { grid = -1; return; }
        if (hipFuncSetAttribute((const void*)fwd_megakernel, hipFuncAttributeMaxDynamicSharedMemorySize, LDS_BYTES) != hipSuccess) { fprintf(stderr, "kernel_launch: hipFuncSetAttribute failed\n"); grid = -1; return; }
        if (hipOccupancyMaxActiveBlocksPerMultiprocessor(&per_cu, (const void*)fwd_megakernel, NTHREADS, LDS_BYTES) != hipSuccess || per_cu < 1) { fprintf(stderr, "kernel_launch: occupancy query says %d\n", per_cu); per_cu = 1; }
        (void)hipGetLastError();
        grid = cus * 1;
    }
    if (grid < 0) return;
    if (hipMemsetAsync((char*)d_ws + WS_BAR, 0, 16384, stream) != hipSuccess) { fprintf(stderr, "kernel_launch: hipMemsetAsync failed\n"); return; }
    Params p{};
    p.x = (const float*)d_in[0]; p.mem = (const float*)d_in[1]; p.pos = (const int*)d_in[2];
    p.w_in = (const float*)d_in[3]; p.b_gate = (const float*)d_in[4]; p.q_norm = (const float*)d_in[5]; p.kv_norm = (const float*)d_in[6];
    p.w_uq = (const float*)d_in[7]; p.w_ukv = (const float*)d_in[8]; p.dlam = (const float*)d_in[9]; p.subln = (const float*)d_in[10];
    p.w_mkv = (const float*)d_in[11]; p.w_br = (const float*)d_in[12]; p.w_out = (const float*)d_in[13]; p.ln1g = (const float*)d_in[14]; p.ln1b = (const float*)d_in[15];
    p.w1 = (const float*)d_in[16]; p.w2 = (const float*)d_in[17]; p.ln2g = (const float*)d_in[18]; p.ln2b = (const float*)d_in[19];
    p.out = (float*)d_out; p.ws = (unsigned char*)d_ws;
    void* args[] = {&p};
    hipError_t e = hipLaunchCooperativeKernel((const void*)fwd_megakernel, dim3(grid), dim3(NTHREADS), args, LDS_BYTES, stream);
    if (e != hipSuccess) fprintf(stderr, "kernel_launch: cooperative launch failed: %s (grid %d)\n", hipGetErrorString(e), grid);
}
```
